# Optimizing an MI355X kernel written in HIP

```python
import jax, jax.numpy as jnp
from jax import lax
import numpy as np


D_MODEL = 2048
BATCH = 1
SEQ = 8192
DEPTH = 1

N_META = 16
EPS = 1e-6

N_HEADS = 16
QK_NOPE_DIM = 128
QK_ROPE_DIM = 64
QK_HEAD_DIM = QK_NOPE_DIM + QK_ROPE_DIM
V_HEAD_DIM = 128
Q_LORA_RANK = 512
KV_LORA_RANK = 512
ROPE_THETA = 10000.0
Q_BLOCK = 128
MLA_WIDTH = N_HEADS * V_HEAD_DIM

POOL_WINDOWS = (2, 4, 8, 16)
POOL_GROUPS = len(POOL_WINDOWS)
POOL_WIDTH = D_MODEL // 2
POOL_GROUP_DIM = POOL_WIDTH // POOL_GROUPS

IN_COLS = Q_LORA_RANK + KV_LORA_RANK + QK_ROPE_DIM + POOL_WIDTH + 2 * D_MODEL
SPLIT_POINTS = (Q_LORA_RANK,
                Q_LORA_RANK + KV_LORA_RANK,
                Q_LORA_RANK + KV_LORA_RANK + QK_ROPE_DIM,
                Q_LORA_RANK + KV_LORA_RANK + QK_ROPE_DIM + POOL_WIDTH,
                Q_LORA_RANK + KV_LORA_RANK + QK_ROPE_DIM + POOL_WIDTH + D_MODEL)

N_EXPERT_GROUPS = 8
EXPERTS_PER_GROUP = 8
N_EXPERTS = N_EXPERT_GROUPS * EXPERTS_PER_GROUP
TOP_K_IN_GROUP = 2
EXPERT_FF = D_MODEL // 4
EXPERT_BLOCK = 128

kernel_name = 'hybrid_mla_pool_hmoe'


def rms_norm(x, w):
    xf = x.astype(jnp.float32)
    y = xf * lax.rsqrt(jnp.mean(xf * xf, axis=-1, keepdims=True) + EPS)
    return (y * w.astype(jnp.float32)).astype(x.dtype)


def rope_tables(length):
    inv = 1.0 / (ROPE_THETA ** (jnp.arange(0, QK_ROPE_DIM, 2, dtype=jnp.float32) / QK_ROPE_DIM))
    ang = jnp.arange(length, dtype=jnp.float32)[:, None] * inv[None, :]
    return jnp.cos(ang), jnp.sin(ang)


def apply_rope(x, cos, sin):
    half = QK_ROPE_DIM // 2
    xf = x.astype(jnp.float32)
    x1, x2 = xf[..., :half], xf[..., half:]
    return jnp.concatenate([x1 * cos - x2 * sin, x1 * sin + x2 * cos], axis=-1).astype(x.dtype)


def mla_attention(c_q, c_kv, k_rope, q_norm_w, w_uq, kv_norm_w, w_ukv, cos, sin):
    B, L, _ = c_q.shape
    q = (rms_norm(c_q, q_norm_w) @ w_uq).reshape(B, L, N_HEADS, QK_HEAD_DIM)
    q_nope, q_pe = q[..., :QK_NOPE_DIM], q[..., QK_NOPE_DIM:]
    q_pe = apply_rope(q_pe, cos[None, :, None, :], sin[None, :, None, :])
    kv = (rms_norm(c_kv, kv_norm_w) @ w_ukv).reshape(B, L, N_HEADS, QK_NOPE_DIM + V_HEAD_DIM)
    k_nope, v = kv[..., :QK_NOPE_DIM], kv[..., QK_NOPE_DIM:]
    k_pe = apply_rope(k_rope, cos[None], sin[None])
    q = jnp.concatenate([q_nope, q_pe], axis=-1)
    k = jnp.concatenate([k_nope, jnp.broadcast_to(k_pe[:, :, None, :], (B, L, N_HEADS, QK_ROPE_DIM))], axis=-1)
    Lp = -(-L // Q_BLOCK) * Q_BLOCK
    pad = ((0, 0), (0, Lp - L), (0, 0), (0, 0))
    q, k, v = jnp.pad(q, pad), jnp.pad(k, pad), jnp.pad(v, pad)
    n_blocks = Lp // Q_BLOCK
    q_blocks = q.reshape(B, n_blocks, Q_BLOCK, N_HEADS, QK_HEAD_DIM).transpose(1, 0, 2, 3, 4)
    kpos = jnp.arange(Lp)
    scale = QK_HEAD_DIM ** -0.5

    def attend_block(args):
        q_blk, blk = args
        s = jnp.einsum('bqhd,bkhd->bhqk', q_blk, k).astype(jnp.float32) * scale
        qpos = blk * Q_BLOCK + jnp.arange(Q_BLOCK)
        causal = kpos[None, :] <= qpos[:, None]
        s = jnp.where(causal[None, None], s, jnp.finfo(jnp.float32).min)
        p = jax.nn.softmax(s, axis=-1).astype(v.dtype)
        return jnp.einsum('bhqk,bkhd->bqhd', p, v)

    o = lax.map(attend_block, (q_blocks, jnp.arange(n_blocks)))
    return o.transpose(1, 0, 2, 3, 4).reshape(B, Lp, MLA_WIDTH)[:, :L]


def multiscale_pool(u, pool_w, pool_scale):
    B, L, C = u.shape
    uf = u.astype(jnp.float32)
    csum = jnp.concatenate([jnp.zeros((B, 1, C), jnp.float32), lax.cumsum(uf, axis=1)], axis=1)
    t = jnp.arange(L)
    outs = []
    for g, w in enumerate(POOL_WINDOWS):
        lo, hi = g * POOL_GROUP_DIM, (g + 1) * POOL_GROUP_DIM
        start = jnp.maximum(t + 1 - w, 0)
        total = csum[:, 1:, lo:hi] - csum[:, start, lo:hi]
        count = (t + 1 - start).astype(jnp.float32)
        outs.append(total / count[None, :, None] - uf[:, :, lo:hi])
    pooled = jnp.stack(outs, axis=2).astype(u.dtype)
    mixed = jnp.einsum('blgc,gcd->blgd', pooled, pool_w).reshape(B, L, POOL_WIDTH)
    return mixed * pool_scale


def hybrid_mixer(a, w_in, q_norm_w, w_uq, kv_norm_w, w_ukv, w_o_mla, pool_w, pool_scale,
                 w_pool_out, w_out, cos, sin):
    proj = a @ w_in
    c_q, c_kv, k_rope, u_pool, gate_mla, gate_pool = jnp.split(proj, SPLIT_POINTS, axis=-1)
    y_mla = mla_attention(c_q, c_kv, k_rope, q_norm_w, w_uq, kv_norm_w, w_ukv, cos, sin) @ w_o_mla
    y_pool = multiscale_pool(u_pool, pool_w, pool_scale) @ w_pool_out
    merged = jax.nn.sigmoid(gate_mla) * y_mla + jax.nn.sigmoid(gate_pool) * y_pool
    return merged @ w_out


def routed_experts(xt, expert_ids, weights, w_gate, w_up, w_down):
    T, D = xt.shape
    A = T * TOP_K_IN_GROUP
    n_blocks = -(-(A + N_EXPERTS * (EXPERT_BLOCK - 1)) // EXPERT_BLOCK)
    cap = n_blocks * EXPERT_BLOCK
    flat_e = expert_ids.reshape(A)
    order = jnp.argsort(flat_e)
    sorted_e = flat_e[order]
    counts = jnp.bincount(flat_e, length=N_EXPERTS)
    padded = (counts + EXPERT_BLOCK - 1) // EXPERT_BLOCK * EXPERT_BLOCK
    seg_start = jnp.cumsum(counts) - counts
    pad_end = jnp.cumsum(padded)
    pad_start = pad_end - padded
    dest = pad_start[sorted_e] + (jnp.arange(A) - seg_start[sorted_e])
    slot_token = jnp.full((cap,), T, jnp.int32).at[dest].set((order // TOP_K_IN_GROUP).astype(jnp.int32))
    slot_weight = jnp.zeros((cap,), xt.dtype).at[dest].set(weights.reshape(A)[order].astype(xt.dtype))
    block_expert = jnp.minimum(jnp.searchsorted(pad_end, jnp.arange(n_blocks) * EXPERT_BLOCK, side='right'),
                               N_EXPERTS - 1)
    x_pad = jnp.concatenate([xt, jnp.zeros((1, D), xt.dtype)], axis=0)
    xb = x_pad[slot_token].reshape(n_blocks, EXPERT_BLOCK, D)

    def expert_block(args):
        x_blk, e = args
        hdn = jax.nn.silu(x_blk @ w_gate[e]) * (x_blk @ w_up[e])
        return hdn @ w_down[e]

    yb = lax.map(expert_block, (xb, block_expert)).reshape(cap, D)
    out = jnp.zeros((T + 1, D), xt.dtype).at[slot_token].add(yb * slot_weight[:, None])
    return out[:T]


def hierarchical_moe(b, w_router_group, b_router_group, w_router_expert, b_router_expert,
                     w_exp_gate, w_exp_up, w_exp_down):
    B, L, D = b.shape
    T = B * L
    xt = b.reshape(T, D)
    g_logits = (xt @ w_router_group).astype(jnp.float32) + b_router_group.astype(jnp.float32)
    p_group = jax.nn.softmax(g_logits, axis=-1)
    _, g_idx = lax.top_k(g_logits, 1)
    p_g = jnp.take_along_axis(p_group, g_idx, axis=-1)
    e_logits = ((xt @ w_router_expert).astype(jnp.float32) + b_router_expert.astype(jnp.float32)).reshape(
        T, N_EXPERT_GROUPS, EXPERTS_PER_GROUP)
    e_in_group = jnp.take_along_axis(e_logits, g_idx[:, :, None], axis=1)[:, 0]
    e_val, e_idx = lax.top_k(e_in_group, TOP_K_IN_GROUP)
    weights = p_g * jax.nn.softmax(e_val, axis=-1)
    expert_ids = g_idx * EXPERTS_PER_GROUP + e_idx
    y = routed_experts(xt, expert_ids, weights, w_exp_gate, w_exp_up, w_exp_down)
    return y.reshape(B, L, D)


def setup_inputs(seed: int = 0) -> dict:
    key = jax.random.key(seed)
    ks = jax.random.split(key, 24)
    f32 = jnp.float32

    def dense(k, shape, fan_in):
        return jax.random.normal(k, shape, f32) * fan_in ** -0.5

    def gain(k, shape, noise=0.05):
        return 1.0 + noise * jax.random.normal(k, shape, f32)

    return {
        'x': jax.random.normal(ks[0], (BATCH, SEQ, D_MODEL), f32),
        'meta_tokens': jax.random.normal(ks[1], (N_META, D_MODEL), f32),
        'norm_mix_w': gain(ks[2], (DEPTH, D_MODEL)),
        'w_in': dense(ks[3], (DEPTH, D_MODEL, IN_COLS), D_MODEL),
        'q_norm_w': gain(ks[4], (DEPTH, Q_LORA_RANK)),
        'w_uq': dense(ks[5], (DEPTH, Q_LORA_RANK, N_HEADS * QK_HEAD_DIM), Q_LORA_RANK),
        'kv_norm_w': gain(ks[6], (DEPTH, KV_LORA_RANK)),
        'w_ukv': dense(ks[7], (DEPTH, KV_LORA_RANK, N_HEADS * (QK_NOPE_DIM + V_HEAD_DIM)), KV_LORA_RANK),
        'w_o_mla': dense(ks[8], (DEPTH, MLA_WIDTH, D_MODEL), MLA_WIDTH),
        'pool_w': dense(ks[9], (DEPTH, POOL_GROUPS, POOL_GROUP_DIM, POOL_GROUP_DIM), POOL_GROUP_DIM),
        'pool_scale': gain(ks[10], (DEPTH, POOL_WIDTH), 0.1),
        'w_pool_out': dense(ks[11], (DEPTH, POOL_WIDTH, D_MODEL), POOL_WIDTH),
        'w_out': dense(ks[12], (DEPTH, D_MODEL, D_MODEL), D_MODEL),
        'norm_ffn_w': gain(ks[13], (DEPTH, D_MODEL)),
        'w_router_group': dense(ks[14], (DEPTH, D_MODEL, N_EXPERT_GROUPS), D_MODEL),
        'b_router_group': 0.01 * jax.random.normal(ks[15], (DEPTH, N_EXPERT_GROUPS), f32),
        'w_router_expert': dense(ks[16], (DEPTH, D_MODEL, N_EXPERTS), D_MODEL),
        'b_router_expert': 0.01 * jax.random.normal(ks[17], (DEPTH, N_EXPERTS), f32),
        'w_exp_gate': dense(ks[18], (DEPTH, N_EXPERTS, D_MODEL, EXPERT_FF), D_MODEL),
        'w_exp_up': dense(ks[19], (DEPTH, N_EXPERTS, D_MODEL, EXPERT_FF), D_MODEL),
        'w_exp_down': dense(ks[20], (DEPTH, N_EXPERTS, EXPERT_FF, D_MODEL), EXPERT_FF),
        'final_norm_w': gain(ks[21], (D_MODEL,)),
    }


def reference(x, meta_tokens, norm_mix_w, w_in, q_norm_w, w_uq, kv_norm_w, w_ukv, w_o_mla,
              pool_w, pool_scale, w_pool_out, w_out, norm_ffn_w, w_router_group, b_router_group,
              w_router_expert, b_router_expert, w_exp_gate, w_exp_up, w_exp_down, final_norm_w):
    B = x.shape[0]
    meta = jnp.broadcast_to(meta_tokens[None].astype(x.dtype), (B, N_META, D_MODEL))
    h = jnp.concatenate([meta, x], axis=1)
    cos, sin = rope_tables(h.shape[1])
    for layer in range(DEPTH):
        a = rms_norm(h, norm_mix_w[layer])
        h = h + hybrid_mixer(a, w_in[layer], q_norm_w[layer], w_uq[layer], kv_norm_w[layer],
                             w_ukv[layer], w_o_mla[layer], pool_w[layer], pool_scale[layer],
                             w_pool_out[layer], w_out[layer], cos, sin)
        bn = rms_norm(h, norm_ffn_w[layer])
        h = h + hierarchical_moe(bn, w_router_group[layer], b_router_group[layer],
                                 w_router_expert[layer], b_router_expert[layer],
                                 w_exp_gate[layer], w_exp_up[layer], w_exp_down[layer])
    h = rms_norm(h, final_norm_w)
    return h[:, N_META:]
```

```cpp
#include <hip/hip_runtime.h>
#include <hip/hip_cooperative_groups.h>
#include <cstdint>
#include <cstddef>
#include <cstdio>
namespace mk {
namespace cg = cooperative_groups;
#define LAS __attribute__((address_space(3)))
#define GAS __attribute__((address_space(1)))
typedef unsigned short bf16_t;
typedef short bf16x8 __attribute__((ext_vector_type(8)));
typedef short s16x4 __attribute__((ext_vector_type(4)));
typedef float f32x4 __attribute__((ext_vector_type(4)));
typedef float f32x2 __attribute__((ext_vector_type(2)));
typedef float f32x16 __attribute__((ext_vector_type(16)));
typedef unsigned u32x4 __attribute__((ext_vector_type(4)));
typedef unsigned u32x2 __attribute__((ext_vector_type(2)));
typedef __bf16 bf16x2_t __attribute__((ext_vector_type(2)));

constexpr int D = 2048, SEQ = 8192, NMETA = 16, LTOT = SEQ + NMETA;
constexpr int NH = 16, QKD = 192, VD = 128;
constexpr int KROWS = SEQ + 64;
constexpr int NE = 64, FF = 512;
constexpr float EPS = 1e-6f;
constexpr int NWAVES = 8, NTHR = 512;

__device__ __forceinline__ unsigned cvtpk(float lo, float hi) { f32x2 v = {lo, hi}; bf16x2_t b = __builtin_convertvector(v, bf16x2_t); return __builtin_bit_cast(unsigned, b); }
__device__ __forceinline__ float bf2f(unsigned short b) { return __uint_as_float((unsigned)b << 16); }
__device__ __forceinline__ float bflo(unsigned w) { return __uint_as_float(w << 16); }
__device__ __forceinline__ float bfhi(unsigned w) { return __uint_as_float(w & 0xffff0000u); }
__device__ __forceinline__ unsigned short f2bf(float f) { return (unsigned short)(cvtpk(f, 0.f) & 0xffffu); }
__device__ __forceinline__ float wave_sum(float v) {
#pragma unroll
    for (int o = 1; o < 64; o <<= 1) v += __shfl_xor(v, o);
    return v;
}
__device__ __forceinline__ int lane_id() { unsigned m = ~0u; asm volatile("" : "+s"(m)); return (int)__builtin_amdgcn_mbcnt_hi(m, __builtin_amdgcn_mbcnt_lo(m, 0u)); }
__device__ __forceinline__ int opaque_tid(int wave) { return wave * 64 + lane_id(); }
__device__ __forceinline__ float sigmoidf_(float x) { return __builtin_amdgcn_rcpf(1.f + __builtin_amdgcn_exp2f(-1.4426950408889634f * x)); }

#define XB_TMO      128
#define XB_XCNT(j)  (256  + 64 * (j))
#define XB_XSUB(j)  (1280 + 64 * (j))
#define XB_XGEN(j)  (2304 + 64 * (j))
#define XB_TOP      3328
#define XB_TOPGEN   3392
#define XCD_BAR_WORDS 3456
#define XB_SPIN_CAP (1u << 20)
__device__ __forceinline__ unsigned xb_ld(unsigned* p)              { return __hip_atomic_load(p, __ATOMIC_RELAXED, __HIP_MEMORY_SCOPE_AGENT); }
__device__ __forceinline__ unsigned xb_add(unsigned* p, unsigned v) { return __hip_atomic_fetch_add(p, v, __ATOMIC_RELAXED, __HIP_MEMORY_SCOPE_AGENT); }
__device__ __forceinline__ unsigned xb_xcc_id() { return (unsigned)__builtin_amdgcn_s_getreg((3 << 11) | 20) & 0xFu; }
#define XB_SPIN(cond, bar) do { unsigned _sp = 0; while (cond) { __builtin_amdgcn_s_sleep(1); \
    if ((++_sp & 255u) == 0u) { if (xb_ld(&(bar)[XB_TMO])) break; if (_sp > XB_SPIN_CAP) { atomicAdd(&(bar)[XB_TMO], 1u); break; } } } } while (0)
struct XcdBarrier { unsigned* bar; unsigned x; volatile LAS unsigned* st; };
__device__ __forceinline__ XcdBarrier xcd_barrier_post(unsigned* bar, volatile LAS unsigned* st) {
    XcdBarrier b; b.bar = bar; b.x = xb_xcc_id(); b.st = st;
    if (threadIdx.x == 0) (void)xb_add(&bar[XB_XCNT(b.x)], 1u);
    return b;
}
__device__ __forceinline__ void xcd_barrier_complete(unsigned* bar, unsigned x, unsigned& nloc, unsigned& nx) {
    const unsigned G = gridDim.x * gridDim.y * gridDim.z;
    unsigned sum, cnt, mine, sp = 0u;
    for (;;) {
        sum = 0u; cnt = 0u; mine = 0u;
#pragma unroll
        for (unsigned j = 0; j < 16; ++j) { const unsigned c = xb_ld(&bar[XB_XCNT(j)]); sum += c; cnt += (c > 0u) ? 1u : 0u; mine = (j == x) ? c : mine; }
        if (sum == G) break;
        __builtin_amdgcn_s_sleep(1);
        if ((++sp & 255u) == 0u) { if (xb_ld(&bar[XB_TMO])) break; if (sp > XB_SPIN_CAP) { atomicAdd(&bar[XB_TMO], 1u); break; } }
    }
    nloc = mine > 0u ? mine : 1u; nx = cnt > 0u ? cnt : 1u;
}
__device__ __forceinline__ void xcd_barrier(const XcdBarrier& b) {
    asm volatile("s_waitcnt vmcnt(0)" ::: "memory");
    __syncthreads();
    if (threadIdx.x == 0) {
        unsigned* bar = b.bar;
        __builtin_amdgcn_s_waitcnt(0);
        unsigned nloc = b.st[0], nx = b.st[1];
        if (nloc == 0u) { xcd_barrier_complete(bar, b.x, nloc, nx); b.st[0] = nloc; b.st[1] = nx; }
        const unsigned old = xb_add(&bar[XB_XSUB(b.x)], 1u);
        const unsigned gen = old / nloc;
        if (old + 1u == (gen + 1u) * nloc) {
            __builtin_amdgcn_fence(__ATOMIC_RELEASE, "agent");
            asm volatile("s_waitcnt vmcnt(0)" ::: "memory");
            const unsigned og = xb_add(&bar[XB_TOP], 1u);
            const unsigned tg = og / nx;
            if (og + 1u == (tg + 1u) * nx) xb_add(&bar[XB_TOPGEN], 1u);
            else XB_SPIN(xb_ld(&bar[XB_TOPGEN]) == tg, bar);
            __builtin_amdgcn_fence(__ATOMIC_ACQUIRE, "agent");
            xb_add(&bar[XB_XGEN(b.x)], 1u);
            asm volatile("s_waitcnt vmcnt(0)" ::: "memory");
        } else {
            XB_SPIN(xb_ld(&bar[XB_XGEN(b.x)]) == gen, bar);
            __builtin_amdgcn_fence(__ATOMIC_ACQUIRE, "agent");
            asm volatile("s_waitcnt vmcnt(0)" ::: "memory");
        }
    }
    __syncthreads();
}

namespace pg8 {
constexpr int BM = 256, BK = 64, HALF = 128, HTB = HALF * BK * 2, STAGE_BYTES = 8 * HTB;
__host__ __device__ __forceinline__ int lds_byte(int r, int c) { const int st = (r >> 4) * 2 + (c >> 5), rr = r & 15, cc = c & 31, ob = rr * 64 + cc * 2; return st * 1024 + (ob ^ (((ob >> 9) & 1) << 5)); }
__host__ __device__ __forceinline__ void stage_rc(int b, int& R, int& C) { const int st = b / 1024, sb = b % 1024, swz = sb ^ (((sb >> 9) & 1) << 5); R = (st >> 1) * 16 + swz / 64; C = (st & 1) * 32 + (swz % 64) / 2; }
__host__ __device__ __forceinline__ int perm32(int rho) { const int n = rho >> 4, i = rho & 15; return 8 * (i >> 2) + 4 * n + (i & 3); }

struct GUnit { const char* A; const char* B; int nt; int pm, pn, aux; };

template <bool GATH, class Sched> __device__ __forceinline__ unsigned arow_off(const Sched& S, const GUnit& u, int r, int lda_b) {
    if constexpr (GATH) return (unsigned)S.arow(u, r); else return (unsigned)(r * lda_b);
}
template <class Epi, class Sched, bool GATH = false, bool ACCINIT = false, bool CARRY = false, bool EARLY = false>
__device__ __forceinline__ void gemm_phase(const int wave_, LAS unsigned char* lds, const int lda_b, const int ldb_b, const Sched& S, const Epi& E) {
    const int wid = wave_, lane = lane_id(), tid = wid * 64 + lane, wr = wid >> 2, wc = wid & 3, fr = lane & 15, fq = lane >> 4;
    int sR[2], sC[2];
    unsigned voffA[2][2], voffB[2];
#pragma unroll
    for (int i = 0; i < 2; ++i) { int R, C; stage_rc(tid * 16 + i * 8192, R, C); sR[i] = R; sC[i] = C; const int Rb = (R & ~31) + perm32(R & 31);
        voffB[i] = (unsigned)(Rb * ldb_b + C * 2); }
    const size_t kstep = (size_t)(BK * 2);
    const size_t hstepB = (size_t)HALF * ldb_b;
    const unsigned ldsw = (unsigned)wid * 1024u;
    const int aoff = lds_byte(wr * 64 + fr, fq * 8), boff = lds_byte(wc * 32 + fr, fq * 8);
#define PG8_SA(b, h) (((b) * 2 + (h)) * HTB)
#define PG8_SB(b, h) ((4 + (b) * 2 + (h)) * HTB)
#define PG8_STAGE(bufoff, gbase, voff) do { _Pragma("unroll") for (int _i = 0; _i < 2; ++_i) \
        __builtin_amdgcn_global_load_lds((const unsigned*)((const char*)(gbase) + (voff)[_i]), (LAS unsigned*)(lds + (bufoff) + ldsw + _i * 8192), 16, 0, 0); } while (0)
#define PG8_LDA(dst, b, h) do { _Pragma("unroll") for (int m = 0; m < 4; ++m) _Pragma("unroll") for (int k = 0; k < 2; ++k) dst[m][k] = *(const LAS bf16x8*)(lds + PG8_SA(b, h) + aoff + m * 2048 + k * 1024); } while (0)
#define PG8_LDB(dst, b, h) do { _Pragma("unroll") for (int n = 0; n < 2; ++n) _Pragma("unroll") for (int k = 0; k < 2; ++k) dst[n][k] = *(const LAS bf16x8*)(lds + PG8_SB(b, h) + boff + n * 2048 + k * 1024); } while (0)
#define PG8_MMA(ai, bj, At, Bt) do { __builtin_amdgcn_s_setprio(1); _Pragma("unroll") for (int m = 0; m < 4; ++m) _Pragma("unroll") for (int n = 0; n < 2; ++n) _Pragma("unroll") for (int k = 0; k < 2; ++k) \
        acc[ai][bj][m][n] = __builtin_amdgcn_mfma_f32_16x16x32_bf16(Bt[n][k], At[m][k], acc[ai][bj][m][n], 0, 0, 0); __builtin_amdgcn_s_setprio(0); } while (0)
#define PG8_WAIT_V(n) asm volatile("s_waitcnt vmcnt(" #n ")" ::: "memory")
#define PG8_WAIT_L(n) asm volatile("s_waitcnt lgkmcnt(" #n ")" ::: "memory")
#define PG8_BAR __builtin_amdgcn_s_barrier()
#define PG8_SCHED __builtin_amdgcn_sched_barrier(0)
#define PG8_VOFFA(dst, u) do { _Pragma("unroll") for (int _h = 0; _h < 2; ++_h) _Pragma("unroll") for (int _i = 0; _i < 2; ++_i) \
        dst[_h][_i] = arow_off<GATH>(S, u, _h * HALF + sR[_i], lda_b) + (unsigned)(sC[_i] * 2); } while (0)
    GUnit cur, nxt; int ui = 0; bool post = false; (void)post;
    if (!S.next(0, cur)) return;
    f32x4 acc[2][2][4][2];
    if constexpr (ACCINIT) E.init(acc, cur, wr, wc, fr, fq);
    else {
#pragma unroll
    for (int a = 0; a < 2; ++a)
#pragma unroll
        for (int b = 0; b < 2; ++b)
#pragma unroll
            for (int m = 0; m < 4; ++m)
#pragma unroll
                for (int n = 0; n < 2; ++n) acc[a][b][m][n] = (f32x4){0.f, 0.f, 0.f, 0.f};
    }
    bf16x8 At[4][2], B0[2][2], B1[2][2];
    const char* cA = cur.A; const char* cB = cur.B;
    PG8_VOFFA(voffA, cur);
    unsigned voffN[2][2];
#pragma unroll
    for (int h = 0; h < 2; ++h)
#pragma unroll
        for (int i = 0; i < 2; ++i) voffN[h][i] = voffA[h][i];
    PG8_STAGE(PG8_SB(0, 0), cB, voffB); PG8_STAGE(PG8_SB(0, 1), cB + hstepB, voffB); PG8_STAGE(PG8_SA(0, 0), cA, voffA[0]); PG8_STAGE(PG8_SA(0, 1), cA, voffA[1]);
    if (wr == 1) PG8_BAR;
    PG8_WAIT_V(2); PG8_BAR;
    PG8_STAGE(PG8_SB(1, 0), cB + kstep, voffB); PG8_STAGE(PG8_SA(1, 0), cA + kstep, voffA[0]); PG8_STAGE(PG8_SB(1, 1), cB + hstepB + kstep, voffB);
    PG8_WAIT_V(6); PG8_BAR;
    for (;;) {
        const bool has_next = S.next(ui + 1, nxt);
        const char* nA = has_next ? nxt.A : cA; const char* nB = has_next ? nxt.B : cB;
        if (GATH) { if (has_next) PG8_VOFFA(voffN, nxt); }
        const int nt = cur.nt;
        for (int t = 0; t < nt; t += 2) {
            const bool last = (t == nt - 2);
            const char* a1 = cA + (size_t)(t + 1) * kstep;
            const char* a2 = last ? nA : cA + (size_t)(t + 2) * kstep; const char* b2 = last ? nB : cB + (size_t)(t + 2) * kstep;
            const char* a3 = a2 + kstep; const char* b3 = b2 + kstep;
            unsigned vA2[2][2];
#pragma unroll
            for (int h = 0; h < 2; ++h)
#pragma unroll
                for (int i = 0; i < 2; ++i) vA2[h][i] = (GATH && last) ? voffN[h][i] : voffA[h][i];
            const bool relaxed = EARLY && post && t == 0;
#define PG8_WAIT_VX(NR) do { if (relaxed) PG8_WAIT_V(NR); else PG8_WAIT_V(8); } while (0)
            PG8_LDB(B0, 0, 0); PG8_LDB(B1, 0, 1); PG8_SCHED; PG8_LDA(At, 0, 0); if (!relaxed) PG8_STAGE(PG8_SA(1, 1), a1, voffA[1]);
            PG8_WAIT_VX(26); PG8_WAIT_L(0); PG8_BAR; PG8_MMA(0, 0, At, B0); PG8_MMA(0, 1, At, B1); PG8_BAR; PG8_SCHED;
            PG8_LDA(At, 0, 1); PG8_STAGE(PG8_SB(0, 0), b2, voffB); PG8_STAGE(PG8_SB(0, 1), b2 + hstepB, voffB); PG8_STAGE(PG8_SA(0, 0), a2, vA2[0]);
            PG8_WAIT_VX(30); PG8_WAIT_L(0); PG8_BAR; PG8_MMA(1, 0, At, B0); PG8_MMA(1, 1, At, B1); PG8_BAR; PG8_SCHED;
            PG8_LDB(B0, 1, 0); PG8_LDB(B1, 1, 1); PG8_SCHED; PG8_LDA(At, 1, 0); PG8_STAGE(PG8_SA(0, 1), a2, vA2[1]);
            PG8_WAIT_VX(26); PG8_WAIT_L(0); PG8_BAR; PG8_MMA(0, 0, At, B0); PG8_MMA(0, 1, At, B1); PG8_BAR; PG8_SCHED;
            PG8_LDA(At, 1, 1); PG8_STAGE(PG8_SB(1, 0), b3, voffB); PG8_STAGE(PG8_SB(1, 1), b3 + hstepB, voffB); PG8_STAGE(PG8_SA(1, 0), a3, vA2[0]);
            PG8_WAIT_VX(30); PG8_WAIT_L(0); PG8_BAR; PG8_MMA(1, 0, At, B0); PG8_MMA(1, 1, At, B1); PG8_BAR; PG8_SCHED;
#undef PG8_WAIT_VX
        }
        if (wr == 0) PG8_BAR;
        if constexpr (EARLY) { post = has_next && E.nstores(cur) >= 16;
            if (post) PG8_STAGE(PG8_SA(1, 1), nA + kstep, (GATH ? voffN[1] : voffA[1])); }
        bool carried = false;
        const int le_ = lane_id(), fre = le_ & 15, fqe = le_ >> 4;
        if constexpr (CARRY) { if (has_next && E.carry(cur)) { E.rescale(acc, cur, wr, wc, fre, fqe); carried = true; } }
        if (!carried) E(acc, cur, wr, wc, fre, fqe);
        if (!has_next) break;
        if constexpr (ACCINIT) E.init(acc, nxt, wr, wc, fre, fqe);
        else if (!carried) {
#pragma unroll
        for (int a = 0; a < 2; ++a)
#pragma unroll
            for (int b = 0; b < 2; ++b)
#pragma unroll
                for (int m = 0; m < 4; ++m)
#pragma unroll
                    for (int n = 0; n < 2; ++n) acc[a][b][m][n] = (f32x4){0.f, 0.f, 0.f, 0.f};
        }
        cur = nxt; cA = nA; cB = nB; ++ui;
        if (GATH) {
#pragma unroll
            for (int h = 0; h < 2; ++h)
#pragma unroll
                for (int i = 0; i < 2; ++i) voffA[h][i] = voffN[h][i];
        }
        if (wr == 1) PG8_BAR;
    }
    PG8_WAIT_V(0);
    PG8_BAR;
#undef PG8_SA
#undef PG8_SB
#undef PG8_STAGE
#undef PG8_LDA
#undef PG8_LDB
#undef PG8_MMA
#undef PG8_WAIT_V
#undef PG8_WAIT_L
#undef PG8_BAR
#undef PG8_SCHED
#undef PG8_VOFFA
}
struct TileOrder {
    int nM, nN, nwg, G, c;
    __device__ __forceinline__ void init(int nM_, int nN_, int G_, int c_) { nM = nM_; nN = nN_; nwg = nM * nN; G = G_; c = c_; }
    __device__ __forceinline__ bool tile(int i, int& pm, int& pn) const {
        const long Lq = (long)i * G + c; if (Lq >= nwg) return false;
        int wgid = (int)Lq; { const int q = nwg / 8, r = nwg % 8, xcd = wgid % 8, off = wgid / 8; wgid = (xcd < r ? xcd * (q + 1) : r * (q + 1) + (xcd - r) * q) + off; }
        const int nig = 8 * nN, gid = wgid / nig, fm = gid * 8, gsz = (nM - fm) < 8 ? (nM - fm) : 8;
        pm = fm + ((wgid % nig) % gsz); pn = (wgid % nig) / gsz; return true;
    }
};
}
}
namespace mk { namespace at {
constexpr int SHM_K = 64 * 192 * 2, SHM_V = 64 * 128 * 2;
constexpr int LDS_V = 0, LDS_K = 2 * SHM_V, LDS_WS = LDS_K + 2 * SHM_K, LDS_QR = LDS_WS + 8 * 256, LDS_TOTAL = LDS_QR + 8 * 4096;
constexpr float THRL = 11.5f;
#define KSWZ(row, colB) ((row) * 256 + ((colB) ^ (((row) & 15) << 4)))
#define SBAR() __builtin_amdgcn_sched_barrier(0)
__device__ __forceinline__ int v_st(int k, int c) { const int kk = (k & ~0xC) | ((k & 4) << 1) | ((k & 8) >> 1); return ((kk >> 3) * 4 + (c >> 5)) * 512 + ((kk & 7) * 32 + (c & 31)) * 2; }
__device__ __forceinline__ int v_rd_base(int lane) { return ((lane & 3) << 3) | (((lane >> 2) & 3) << 6) | (((lane >> 4) & 1) << 5) | (((lane >> 5) & 1) << 8); }
constexpr int v_rd_off(int d0, int ks, int half) { return d0 * 512 + ks * 4096 + half * 2048; }
__device__ __forceinline__ int crow(int r, int hi) { return (r & 3) + 8 * (r >> 2) + 4 * hi; }

__device__ __forceinline__ void mask_causal(f32x16& p0, f32x16& p1, int dq) {
    const float NEG = -__builtin_inff();
#pragma unroll
    for (int r = 0; r < 16; ++r) { const int c = (r & 3) + 8 * (r >> 2); if (dq - c < 0) p0[r] = NEG; if (dq - c - 32 < 0) p1[r] = NEG; }
}
__device__ __forceinline__ void mask_meta(f32x16& p0, f32x16& p1) {
    const float NEG = -__builtin_inff();
#pragma unroll
    for (int r = 0; r < 16; ++r) { if (r >= 8) p0[r] = NEG; p1[r] = NEG; }
}
__device__ __forceinline__ void partialSM(f32x16& p0, f32x16& p1, float& m_reg, float& alpha) {
    float pmax = p0[0];
#pragma unroll
    for (int r = 1; r < 16; ++r) pmax = fmaxf(pmax, p0[r]);
#pragma unroll
    for (int r = 0; r < 16; ++r) pmax = fmaxf(pmax, p1[r]);
    { auto rr = __builtin_amdgcn_permlane32_swap(__float_as_uint(pmax), __float_as_uint(pmax), false, false);
      pmax = fmaxf(__uint_as_float(rr[0]), __uint_as_float(rr[1])); }
    float mn;
    if (__builtin_expect(__all((pmax - m_reg) <= THRL), 1)) { mn = m_reg; alpha = 1.f; }
    else { mn = fmaxf(m_reg, pmax); alpha = __builtin_amdgcn_exp2f(m_reg - mn); m_reg = mn; }
#pragma unroll
    for (int r = 0; r < 16; ++r) p0[r] = __builtin_amdgcn_exp2f(p0[r] - mn);
#pragma unroll
    for (int r = 0; r < 16; ++r) p1[r] = __builtin_amdgcn_exp2f(p1[r] - mn);
}
__device__ __forceinline__ void finishSM(const f32x16& p0, const f32x16& p1, float alpha, float& l_reg, bf16x8& pa0, bf16x8& pa1, bf16x8& pa2, bf16x8& pa3) {
    float ps = 0.f;
#pragma unroll
    for (int r = 0; r < 16; ++r) ps += p0[r];
#pragma unroll
    for (int r = 0; r < 16; ++r) ps += p1[r];
    { auto rr = __builtin_amdgcn_permlane32_swap(__float_as_uint(ps), __float_as_uint(ps), false, false);
      ps = __uint_as_float(rr[0]) + __uint_as_float(rr[1]); }
    l_reg = l_reg * alpha + ps;
#define PK4(P, B_, OUT) do { unsigned a0 = cvtpk(P[B_+0], P[B_+1]), a1 = cvtpk(P[B_+2], P[B_+3]);                          \
        unsigned b0 = cvtpk(P[B_+4], P[B_+5]), b1 = cvtpk(P[B_+6], P[B_+7]);                                             \
        auto r0 = __builtin_amdgcn_permlane32_swap(a0, b0, false, false); auto r1 = __builtin_amdgcn_permlane32_swap(a1, b1, false, false); \
        u32x4 w = {r0[0], r1[0], r0[1], r1[1]}; OUT = __builtin_bit_cast(bf16x8, w); } while (0)
    PK4(p0, 0, pa0); PK4(p0, 8, pa1); PK4(p1, 0, pa2); PK4(p1, 8, pa3);
#undef PK4
}
template <int KB>
__device__ __forceinline__ void qkt(f32x16& p0, f32x16& p1, const LAS unsigned char* K_lds, int r32, int hi, const bf16x8* qr, const LAS unsigned char* qrl) {
    p0 = f32x16{}; p1 = f32x16{};
    const unsigned kb0 = (unsigned)(size_t)(K_lds + KB * SHM_K) + (unsigned)KSWZ(r32, hi * 16);
    const int f = (r32 >> 1) & 7;
    const LAS unsigned char* krp = K_lds + KB * SHM_K + 16384 + r32 * 128;
#define KLD(d0, h) ((d0) < 8 ? *(const LAS bf16x8*)((size_t)(kb0 ^ (unsigned)((d0) << 5)) + (h) * 32 * 256) \
                             : *(const LAS bf16x8*)(krp + (((((d0) - 8) * 2 + hi) ^ f) << 4) + (h) * 32 * 128))
#define QLD(d0) (*(const LAS bf16x8*)(qrl + (((((d0) - 8) * 2 + hi) ^ f) << 4)))
    bf16x8 ka00, ka01, ka10, ka11, qa0, qa1;
    ka00 = KLD(0, 0); ka01 = KLD(0, 1); ka10 = KLD(1, 0); ka11 = KLD(1, 1);
    __builtin_amdgcn_sched_group_barrier(0x100, 4, 0);
#define QSTEP(d0, A0, A1, QV, NRD) do { \
        p0 = __builtin_amdgcn_mfma_f32_32x32x16_bf16(A0, QV, p0, 0, 0, 0); \
        p1 = __builtin_amdgcn_mfma_f32_32x32x16_bf16(A1, QV, p1, 0, 0, 0); \
        if ((d0) + 2 < 12) { A0 = KLD((d0) + 2, 0); A1 = KLD((d0) + 2, 1); } \
        __builtin_amdgcn_sched_group_barrier(0x008, 2, 0); \
        if ((NRD) > 0) __builtin_amdgcn_sched_group_barrier(0x100, NRD, 0); } while (0)
    QSTEP(0, ka00, ka01, qr[0], 2); QSTEP(1, ka10, ka11, qr[1], 2); QSTEP(2, ka00, ka01, qr[2], 2); QSTEP(3, ka10, ka11, qr[3], 2);
    QSTEP(4, ka00, ka01, qr[4], 2); QSTEP(5, ka10, ka11, qr[5], 2);
    qa0 = QLD(8); QSTEP(6, ka00, ka01, qr[6], 3);
    qa1 = QLD(9); QSTEP(7, ka10, ka11, qr[7], 3);
    { const bf16x8 q8 = qa0; qa0 = QLD(10); QSTEP(8, ka00, ka01, q8, 3); }
    { const bf16x8 q9 = qa1; qa1 = QLD(11); QSTEP(9, ka10, ka11, q9, 3); }
    QSTEP(10, ka00, ka01, qa0, 0); QSTEP(11, ka10, ka11, qa1, 0);
#undef QSTEP
#undef KLD
#undef QLD
}
template <int VB>
__device__ __forceinline__ void pv_tile(f32x16* o, int vb0, bf16x8 pa0, bf16x8 pa1, bf16x8 pa2, bf16x8 pa3) {
#define TRRD(dst, off) asm volatile("ds_read_b64_tr_b16 %0, %1 offset:%2" : "=&v"(dst) : "v"(vb0), "i"(off) : "memory")
#define PV_RD(S, d0) do { constexpr int b_ = VB * SHM_V + v_rd_off(d0, 0, 0); \
        TRRD(S##l0, b_); TRRD(S##h0, b_ + 2048); TRRD(S##l1, b_ + 4096); TRRD(S##h1, b_ + 6144); TRRD(S##l2, b_ + 8192); TRRD(S##h2, b_ + 10240); TRRD(S##l3, b_ + 12288); TRRD(S##h3, b_ + 14336); } while (0)
#define PV_MM(S, d0) do { \
        o[d0] = __builtin_amdgcn_mfma_f32_32x32x16_bf16(pa0, (bf16x8){S##l0[0], S##l0[1], S##l0[2], S##l0[3], S##h0[0], S##h0[1], S##h0[2], S##h0[3]}, o[d0], 0, 0, 0);   \
        o[d0] = __builtin_amdgcn_mfma_f32_32x32x16_bf16(pa1, (bf16x8){S##l1[0], S##l1[1], S##l1[2], S##l1[3], S##h1[0], S##h1[1], S##h1[2], S##h1[3]}, o[d0], 0, 0, 0);   \
        o[d0] = __builtin_amdgcn_mfma_f32_32x32x16_bf16(pa2, (bf16x8){S##l2[0], S##l2[1], S##l2[2], S##l2[3], S##h2[0], S##h2[1], S##h2[2], S##h2[3]}, o[d0], 0, 0, 0);   \
        o[d0] = __builtin_amdgcn_mfma_f32_32x32x16_bf16(pa3, (bf16x8){S##l3[0], S##l3[1], S##l3[2], S##l3[3], S##h3[0], S##h3[1], S##h3[2], S##h3[3]}, o[d0], 0, 0, 0); } while (0)
#define PV_WAIT(N, S) asm volatile("s_waitcnt lgkmcnt(" #N ")" : "+v"(S##l0), "+v"(S##h0), "+v"(S##l1), "+v"(S##h1), "+v"(S##l2), "+v"(S##h2), "+v"(S##l3), "+v"(S##h3) :: "memory")
    s16x4 Al0, Al1, Al2, Al3, Ah0, Ah1, Ah2, Ah3, Bl0, Bl1, Bl2, Bl3, Bh0, Bh1, Bh2, Bh3;
    PV_RD(A, 0); PV_RD(B, 1);
    PV_WAIT(8, A); SBAR(); PV_MM(A, 0); SBAR();
    PV_RD(A, 2);
    PV_WAIT(8, B); SBAR(); PV_MM(B, 1); SBAR();
    PV_RD(B, 3);
    PV_WAIT(8, A); SBAR(); PV_MM(A, 2); SBAR();
    PV_WAIT(0, B); SBAR(); PV_MM(B, 3);
#undef PV_RD
#undef PV_MM
#undef PV_WAIT
#undef TRRD
}

__device__ __forceinline__ void attn_unit(const int wave_, int h, int qb, unsigned char* ws, unsigned wsQ, unsigned wsK, unsigned wsV, unsigned wsO, LAS unsigned char* lds) {
    const int wid = wave_, lane = lane_id(), r32 = lane & 31, hi = lane >> 5;
    LAS unsigned char* V_lds = lds + LDS_V; LAS unsigned char* K_lds = lds + LDS_K;
    LAS float* wsf = (LAS float*)(lds + LDS_WS) + wid * 64; LAS float* li_l = wsf; LAS float* al_l = wsf + 32;
    const int NTT = 4 * qb + 5;
    const int qlo = qb * 256 + wid * 32, qrow = qlo + r32;
    const int vb0 = (int)(size_t)V_lds + v_rd_base(lane);
    unsigned kn_off[2], v_off[2], kr_off;
#pragma unroll
    for (int j = 0; j < 2; ++j) { const int piece = j * 8 + wid;
        { const int row = piece * 4 + (lane >> 4), c = (lane & 15) ^ (row & 15); kn_off[j] = (unsigned)(row * QKD + c * 8) * 2u; }
        { const int sub = piece * 2 + (lane >> 5), kk = (sub >> 2) * 8 + ((lane & 31) >> 2), k = (kk & ~0xC) | ((kk & 4) << 1) | ((kk & 8) >> 1); v_off[j] = (unsigned)(k * VD + (sub & 3) * 32 + (lane & 3) * 8) * 2u; } }
    { const int row = wid * 8 + (lane >> 3), c = (lane & 7) ^ ((row >> 1) & 7); kr_off = (unsigned)(row * QKD + 128 + c * 8) * 2u; }
    LAS unsigned char* ldsA = lds;
#define KVROW(tt) ((tt) == 0 ? SEQ : ((tt) - 1) * 64)
#define SLOAD(tt, bf) do { const unsigned char* kp_ = ws + (wsK + (unsigned)(h * KROWS + KVROW(tt)) * (QKD * 2u)); const unsigned char* vp_ = ws + (wsV + (unsigned)(h * KROWS + KVROW(tt)) * (VD * 2u)); \
        _Pragma("unroll") for (int j_ = 0; j_ < 2; ++j_) { \
            __builtin_amdgcn_global_load_lds((const unsigned*)(kp_ + kn_off[j_]), (LAS unsigned*)(ldsA + LDS_K + (bf) * SHM_K + (j_ * 8 + wid) * 1024), 16, 0, 0); \
            __builtin_amdgcn_global_load_lds((const unsigned*)(vp_ + v_off[j_]), (LAS unsigned*)(ldsA + LDS_V + (bf) * SHM_V + (j_ * 8 + wid) * 1024), 16, 0, 0); } \
        __builtin_amdgcn_global_load_lds((const unsigned*)(kp_ + kr_off), (LAS unsigned*)(ldsA + LDS_K + (bf) * SHM_K + 16384 + wid * 1024), 16, 0, 0); } while (0)
    SLOAD(0, 0);
    bf16x8 qr[8];
    LAS unsigned char* qrl = lds + LDS_QR + wid * 4096 + r32 * 128;
    { const bf16_t* Qw = (const bf16_t*)(ws + wsQ) + ((size_t)h * SEQ + qrow) * QKD + hi * 8;
#pragma unroll
      for (int d0 = 0; d0 < 8; ++d0) qr[d0] = *(const bf16x8*)(Qw + d0 * 16);
      const int f_ = (r32 >> 1) & 7;
#pragma unroll
      for (int dd = 0; dd < 4; ++dd) { const bf16x8 t = *(const bf16x8*)(Qw + 128 + dd * 16); *(LAS bf16x8*)(qrl + (((dd * 2 + hi) ^ f_) << 4)) = t; } }
    asm volatile("s_waitcnt vmcnt(0)" ::: "memory");
    __syncthreads();
    float m_reg = -1e30f, l_reg = 0.f; f32x16 o[4] = {};
    f32x16 p0, p1; bf16x8 pa0, pa1, pa2, pa3;
#define STEP(tt, KB) do { \
        if ((tt) + 1 < NTT) SLOAD((tt) + 1, (KB) ^ 1); \
        const int kbase_ = ((tt) - 1) * 64; \
        const bool act_ = (tt) == 0 || kbase_ <= qlo + 31;               \
        if (act_) { \
            SBAR(); qkt<KB>(p0, p1, K_lds, r32, hi, qr, qrl); \
            if ((tt) == 0) mask_meta(p0, p1); else if (kbase_ + 63 > qlo) mask_causal(p0, p1, qrow - kbase_ - 4 * hi); \
            float alpha_; partialSM(p0, p1, m_reg, alpha_); \
            if (__any(alpha_ < 1.f)) { if (hi == 0) al_l[r32] = alpha_; asm volatile("s_waitcnt lgkmcnt(0)" ::: "memory"); \
                _Pragma("unroll") for (int d_ = 0; d_ < 4; ++d_) _Pragma("unroll") for (int r = 0; r < 16; ++r) o[d_][r] *= al_l[crow(r, hi)]; } \
            finishSM(p0, p1, alpha_, l_reg, pa0, pa1, pa2, pa3); SBAR(); \
            pv_tile<KB>(o, vb0, pa0, pa1, pa2, pa3); \
        } \
        asm volatile("s_waitcnt vmcnt(0)" ::: "memory"); \
        __syncthreads(); } while (0)
    int tt = 0;
    for (; tt + 1 < NTT; tt += 2) { STEP(tt, 0); STEP(tt + 1, 1); }
    STEP(tt, 0);
    if (hi == 0) li_l[r32] = l_reg;
    asm volatile("s_waitcnt lgkmcnt(0)" ::: "memory");
    bf16_t* Ow = (bf16_t*)(ws + wsO) + (size_t)qlo * D + h * VD;
#pragma unroll
    for (int r = 0; r < 16; ++r) { const int orow = crow(r, hi); const float rl = __builtin_amdgcn_rcpf(li_l[orow]);
#pragma unroll
        for (int d0 = 0; d0 < 4; ++d0) { const float v = o[d0][r] * rl; const float vn = __shfl_xor(v, 1);
            if ((r32 & 1) == 0) *(unsigned*)(Ow + (size_t)orow * D + d0 * 32 + r32) = cvtpk(v, vn); } }
    __syncthreads();
#undef STEP
#undef SLOAD
#undef KVROW
}
#undef KSWZ
#undef SBAR
}}
namespace mk { namespace m4 {
constexpr int ROWS = 384, A_ST = ROWS * 64, RAW_ST = 16384, IMG_ST = 8192, NRAW = 4;
constexpr int LDS_A = 0, LDS_RAW = 3 * A_ST, LDS_IMG = LDS_RAW + NRAW * RAW_ST, LDS_TOTAL = LDS_IMG + 2 * IMG_ST;
__device__ __forceinline__ int invperm32(int c) { return 16 * ((c >> 2) & 1) + 4 * (c >> 3) + (c & 3); }
__device__ __forceinline__ int swz(int ob) { return ob ^ (((ob >> 9) & 1) << 5); }
struct MUnit { const char* A; const float* B0; const float* B1; int nK; int pm, aux, ns, koff; };
struct UState { const char* asrc; const char* bsrc; unsigned voffA[3]; int wact; };
template <int MODE, class Sched, class Epi, int ABL = 0>
__device__ __forceinline__ void moe_phase(const int wave_, LAS unsigned char* lds, const Sched& S, const Epi& E, const float* kscale) {
    (void)kscale;
    const int wid = wave_, lane = lane_id(), tid = wid * 64 + lane, fr = lane & 15, fq = lane >> 4;
    constexpr int LDB = MODE == 0 ? 512 : 2048;
    constexpr int LDA = MODE == 0 ? 4096 : 1024;
    const unsigned ldsb = (unsigned)(size_t)lds;
    const int ob_ = swz(lane * 16), arr = ob_ >> 6, acc8 = (ob_ & 63) >> 1;
    unsigned voffB[2];
#pragma unroll
    for (int q = 0; q < 2; ++q) voffB[q] = MODE == 0 ? (unsigned)(((8 * (wid & 3) + 4 * q + (lane >> 4)) * LDB + 4 * (lane & 15)) * 4) : (unsigned)(((4 * wid + 2 * q + (lane >> 5)) * LDB + 4 * (lane & 31)) * 4);
    const int which = MODE == 0 ? (wid >> 2) : 0;
    const int bk4 = MODE == 0 ? 2 * (wid & 3) + (lane >> 5) : wid;
    const int bcol = MODE == 0 ? 2 * (lane & 31) : 2 * lane;
    const unsigned rawoff = MODE == 0 ? (unsigned)(which * 8192 + (bk4 * 4) * 256 + bcol * 4) : (unsigned)((bk4 * 4) * 512 + bcol * 4);
    constexpr int RAWP = MODE == 0 ? 256 : 512;
    unsigned bwoff[2];
#pragma unroll
    for (int jj = 0; jj < 2; ++jj) { const int n = MODE == 0 ? 2 * (bcol + jj) + which : bcol + jj; const int rho = (n & ~31) + invperm32(n & 31); bwoff[jj] = (unsigned)((rho >> 4) * 1024 + swz((rho & 15) * 64 + bk4 * 8)); }
    const int afoff = swz(fr * 64 + fq * 16);
#define M4_USTATE(US, U) do { (US).wact = (wid * 48 < (U).aux - (U).pm) ? 1 : 0; \
        _Pragma("unroll") for (int p_ = 0; p_ < 3; ++p_) { const int r_ = wid * 48 + p_ * 16 + arr; (US).voffA[p_] = (MODE == 0 ? S.arow(U, r_) : (unsigned)(r_ * LDA)) + (unsigned)(acc8 * 2); } \
        { const unsigned long long bb_ = (unsigned long long)((MODE == 0 && wid >= 4) ? (U).B1 : (U).B0), aa_ = (unsigned long long)(U).A; \
          (US).bsrc = (const char*)(((unsigned long long)(unsigned)__builtin_amdgcn_readfirstlane((int)(bb_ >> 32)) << 32) | (unsigned)__builtin_amdgcn_readfirstlane((int)bb_)); \
          (US).asrc = (const char*)(((unsigned long long)(unsigned)__builtin_amdgcn_readfirstlane((int)(aa_ >> 32)) << 32) | (unsigned)__builtin_amdgcn_readfirstlane((int)aa_)); } } while (0)
#define M4_DMA(voff, dst, base, NT) do { unsigned keep_; const unsigned d_ = (unsigned)__builtin_amdgcn_readfirstlane((int)(dst)); \
        if (NT) asm volatile("s_mov_b32 %0, m0\n\ts_mov_b32 m0, %2\n\ts_nop 0\n\tglobal_load_lds_dwordx4 %1, %3 nt\n\ts_mov_b32 m0, %0" : "=&s"(keep_) : "v"(voff), "s"(d_), "s"(base) : "memory"); \
        else asm volatile("s_mov_b32 %0, m0\n\ts_mov_b32 m0, %2\n\ts_nop 0\n\tglobal_load_lds_dwordx4 %1, %3\n\ts_mov_b32 m0, %0" : "=&s"(keep_) : "v"(voff), "s"(d_), "s"(base) : "memory"); } while (0)
#define M4_STAGEA(US, k, st) do { if (!(ABL & 4) && (US).wact) { const char* ab_ = (US).asrc + (size_t)(k) * 64; _Pragma("unroll") for (int p_ = 0; p_ < 3; ++p_) M4_DMA((US).voffA[p_], ldsb + LDS_A + (st) * A_ST + (3 * wid + p_) * 1024, ab_, 0); } } while (0)
#define M4_STAGEB(US, k, st) do { if (!(ABL & 2)) { const char* bb_ = (US).bsrc + (size_t)(k) * (32 * LDB * 4); _Pragma("unroll") for (int q_ = 0; q_ < 2; ++q_) M4_DMA(voffB[q_], ldsb + LDS_RAW + (st) * RAW_ST + (2 * wid + q_) * 1024, bb_, 1); } } while (0)
#define M4_CONVERT(st, buf) do { f32x2 r_[4]; _Pragma("unroll") for (int i_ = 0; i_ < 4; ++i_) r_[i_] = *(const LAS f32x2*)(lds + LDS_RAW + (st) * RAW_ST + rawoff + i_ * RAWP); \
        _Pragma("unroll") for (int jj_ = 0; jj_ < 2; ++jj_) { u32x2 w_; w_.x = cvtpk(r_[0][jj_], r_[1][jj_]); w_.y = cvtpk(r_[2][jj_], r_[3][jj_]); \
            *(LAS u32x2*)(lds + LDS_IMG + (buf) * IMG_ST + bwoff[jj_]) = w_; } } while (0)
#define M4_COMPUTE(st, buf) do { if (!(ABL & 1) && cur.wact) { bf16x8 Af[3], Bf[8]; \
        _Pragma("unroll") for (int m = 0; m < 3; ++m) Af[m] = *(const LAS bf16x8*)(lds + LDS_A + (st) * A_ST + (3 * wid + m) * 1024 + afoff); \
        _Pragma("unroll") for (int n = 0; n < 8; ++n) Bf[n] = *(const LAS bf16x8*)(lds + LDS_IMG + (buf) * IMG_ST + n * 1024 + afoff); \
        _Pragma("unroll") for (int m = 0; m < 3; ++m) _Pragma("unroll") for (int n = 0; n < 8; ++n) acc[m][n] = __builtin_amdgcn_mfma_f32_16x16x32_bf16(Bf[n], Af[m], acc[m][n], 0, 0, 0); } } while (0)
#define M4_WAITV(N) asm volatile("s_waitcnt vmcnt(" #N ")" ::: "memory")
    MUnit ucur, unxt; UState cur, nxt;
    if (!S.next(0, ucur)) return;
    M4_USTATE(cur, ucur);
    const int nK = ucur.nK, kmask = nK - 1;
    bool has_next = S.next(1, unxt);
    if (has_next) M4_USTATE(nxt, unxt); else nxt = cur;
    int koffc = __builtin_amdgcn_readfirstlane(ucur.koff) & kmask, koffn = has_next ? (__builtin_amdgcn_readfirstlane(unxt.koff) & kmask) : 0;
    int a0 = 0, a1 = 1, a2 = 2, wa0 = cur.wact ? 3 : 0, wa1 = wa0;
    asm volatile("s_waitcnt vmcnt(0)" ::: "memory");
    M4_STAGEA(cur, (0 + koffc) & kmask, 0); M4_STAGEA(cur, (1 + koffc) & kmask, 1);
#pragma unroll
    for (int s_ = 0; s_ < 4; ++s_) M4_STAGEB(cur, (s_ + koffc) & kmask, s_);
    M4_WAITV(0);
    __builtin_amdgcn_s_barrier();
    M4_CONVERT(0, 0);
    asm volatile("s_waitcnt lgkmcnt(0)" ::: "memory"); __builtin_amdgcn_s_barrier();
    for (int ui = 0;; ++ui) {
        f32x4 acc[3][8];
#pragma unroll
        for (int m = 0; m < 3; ++m)
#pragma unroll
            for (int n = 0; n < 8; ++n) acc[m][n] = (f32x4){0.f, 0.f, 0.f, 0.f};
#define M4_STEP(t, PAR) do { \
            const bool in1_ = (t) + 1 < nK, in2_ = (t) + 2 < nK, in4_ = (t) + 4 < nK; \
            const int wq_ = wa0 + wa1;                                    \
            if (in1_ || has_next) { if (!(ABL & 6)) { if (wq_ == 6) M4_WAITV(10); else if (wq_ == 3) M4_WAITV(7); else M4_WAITV(4); } M4_CONVERT(((t) + 1) & 3, 1 - (PAR)); } \
            int w2_ = 0; \
            if (in2_) { M4_STAGEA(cur, ((t) + 2 + koffc) & kmask, a2); w2_ = cur.wact; } else if (has_next) { M4_STAGEA(nxt, ((t) + 2 - nK + koffn) & kmask, a2); w2_ = nxt.wact; } \
            if (in4_) M4_STAGEB(cur, ((t) + 4 + koffc) & kmask, (t) & 3); else if (has_next) M4_STAGEB(nxt, ((t) + 4 - nK + koffn) & kmask, (t) & 3); \
            __builtin_amdgcn_sched_barrier(0); \
            M4_COMPUTE(a0, PAR); \
            __builtin_amdgcn_sched_barrier(0); \
            if ((in4_ || has_next) && !(ABL & 6)) { if (w2_) M4_WAITV(7); else M4_WAITV(4); } else M4_WAITV(0); \
            asm volatile("s_waitcnt lgkmcnt(0)" ::: "memory"); __builtin_amdgcn_s_barrier(); \
            { const int s_ = a0; a0 = a1; a1 = a2; a2 = s_; wa0 = wa1; wa1 = w2_ ? 3 : 0; } } while (0)
        for (int t = 0; t < nK; t += 2) { M4_STEP(t, 0); M4_STEP(t + 1, 1); }
#undef M4_STEP
        if (!(ABL & 8)) { if (cur.wact) E(acc, ucur, wid, fr, fq); } else { asm volatile("" :: "v"(acc[0][0]), "v"(acc[1][1]), "v"(acc[2][2])); }
        if (!has_next) break;
        ucur = unxt; cur = nxt; koffc = koffn;
        has_next = S.next(ui + 2, unxt);
        if (has_next) { M4_USTATE(nxt, unxt); koffn = __builtin_amdgcn_readfirstlane(unxt.koff) & kmask; }
    }
    M4_WAITV(0);
    __syncthreads();
#undef M4_USTATE
#undef M4_DMA
#undef M4_STAGEA
#undef M4_STAGEB
#undef M4_CONVERT
#undef M4_COMPUTE
#undef M4_WAITV
}
}}
namespace mk {
constexpr size_t MiB = 1u << 20;
constexpr size_t WS_CTL = 0, CTL_ZERO_BYTES = 1 * MiB;
constexpr size_t WS_WIN = 2 * MiB;
constexpr size_t WS_WQKV = 28 * MiB;
constexpr size_t WS_WO = 36 * MiB;
constexpr size_t WS_WPE = 44 * MiB;
constexpr size_t WS_WOUT = 52 * MiB;
constexpr size_t WS_WR = 60 * MiB;
constexpr size_t WS_ROPE = 61 * MiB;
constexpr size_t WS_XN = 64 * MiB;
constexpr size_t WS_XNM = 96 * MiB;
constexpr size_t WS_SSQ = 97 * MiB;
constexpr size_t WS_CQKV = 98 * MiB;
constexpr size_t WS_U = 116 * MiB;
constexpr size_t WS_G = 133 * MiB;
constexpr size_t WS_Q = 197 * MiB;
constexpr size_t WS_K = 245 * MiB;
constexpr size_t WS_V = 294 * MiB;
constexpr size_t WS_O = 327 * MiB;
constexpr size_t WS_PL = 359 * MiB;
constexpr size_t WS_SS2 = 391 * MiB;
constexpr size_t WS_RT = 393 * MiB;
constexpr size_t WS_WPOT = 396 * MiB;
constexpr size_t WS_PWB = 400 * MiB;
constexpr size_t WS_CQKV2 = 404 * MiB;
constexpr size_t WS_WQKV2 = 436 * MiB;
constexpr size_t WS_WED = 652 * MiB;
constexpr size_t WS_END = 780 * MiB;
constexpr int CW_BAR = 4096;
constexpr int WIN_ROWS = 6400;

constexpr int RING_BYTES = 155648, MISC_OFF = RING_BYTES, LDS_BYTES = 163840;

struct Args { const float* in[22]; float* out; unsigned char* ws; int ph_lo, ph_hi, never, pad; };

struct Frame {
    LAS unsigned char* lds; volatile LAS unsigned* MISC;
    int vcu, G, wave;
    unsigned char* ws;
};
struct Ids { int tid, lane, wave; };
__device__ __forceinline__ Ids phase_ids(int wave) { Ids i; i.wave = wave; i.lane = lane_id(); i.tid = wave * 64 + i.lane; return i; }

enum { MAP_ID = 0, MAP_WIN = 1, MAP_UQ = 2, MAP_EVEN = 3, MAP_ODD = 4 };
__device__ __forceinline__ int ileave64(int i) { return i < 32 ? 2 * i : 2 * (i - 32) + 1; }
template <int KIND> __device__ __forceinline__ int map_row(int n) {
    if (KIND == MAP_WIN) { if (n < 1024) return n; if (n < 1088) return 6144 + ileave64(n - 1024); return n - 64; }
    if (KIND == MAP_UQ) { const int h = n / 192, d = n - h * 192; return d < 128 ? n : h * 192 + 128 + ileave64(d - 128); }
    if (KIND == MAP_EVEN) return 2 * n;
    if (KIND == MAP_ODD) return 2 * n + 1;
    return n;
}
template <int KIND> __device__ __forceinline__ void tile_store_T(const LAS float* scr, bf16_t* WT, int ldt, int row_off, int n0, int k0, int lane) {
    const int c = lane & 7;
#pragma unroll
    for (int j = 0; j < 4; ++j) { const int n = (lane >> 3) + 8 * j; const LAS float* s = scr + (8 * c) * 33 + n;
        u32x4 o; o.x = cvtpk(s[0 * 33], s[1 * 33]); o.y = cvtpk(s[2 * 33], s[3 * 33]); o.z = cvtpk(s[4 * 33], s[5 * 33]); o.w = cvtpk(s[6 * 33], s[7 * 33]);
        *(u32x4*)(WT + (size_t)(row_off + map_row<KIND>(n0 + n)) * ldt + k0 + 8 * c) = o; }
    asm volatile("s_waitcnt lgkmcnt(0)" ::: "memory");
}
template <int KIND> __device__ __forceinline__ void p0_transpose_item(const float* W, int N, bf16_t* WT, int ldt, int row_off, const float* kscale, LAS float* scr, int item, int lane) {
    const int nblk = N / 32, kb = item / nblk, nb = item % nblk, k0 = 64 * kb, n0 = 32 * nb;
    float tv[32];
#pragma unroll
    for (int i = 0; i < 32; ++i) { const int kk = 2 * i + (lane >> 5); tv[i] = W[(size_t)(k0 + kk) * N + n0 + (lane & 31)]; }
#pragma unroll
    for (int i = 0; i < 32; ++i) { const int kk = 2 * i + (lane >> 5); float v = tv[i]; if (kscale) v *= kscale[k0 + kk]; scr[kk * 33 + (lane & 31)] = v; }
    asm volatile("s_waitcnt lgkmcnt(0)" ::: "memory");
    tile_store_T<KIND>(scr, WT, ldt, row_off, n0, k0, lane);
}
__device__ __forceinline__ void rms_row_to_bf16(const float* xrow, const float* w, bf16_t* orow, int lane) {
    const f32x4* xr = (const f32x4*)xrow + lane; const f32x4* wr4 = (const f32x4*)w + lane;
    f32x4 v[8]; float s = 0.f;
#pragma unroll
    for (int j = 0; j < 8; ++j) { v[j] = xr[64 * j]; s += (v[j].x * v[j].x + v[j].y * v[j].y) + (v[j].z * v[j].z + v[j].w * v[j].w); }
    const float rstd = rsqrtf(wave_sum(s) * (1.f / D) + EPS);
    u32x2* o8 = (u32x2*)orow + lane;
#pragma unroll
    for (int j = 0; j < 8; ++j) { const f32x4 ww = wr4[64 * j]; u32x2 o; o.x = cvtpk(v[j].x * rstd * ww.x, v[j].y * rstd * ww.y); o.y = cvtpk(v[j].z * rstd * ww.z, v[j].w * rstd * ww.w); o8[64 * j] = o; }
}

__device__ __forceinline__ void rms_row2_to_bf16(const float* x0, const float* x1, const float* w, bf16_t* o0, bf16_t* o1, int lane) {
    const f32x4* xr0 = (const f32x4*)x0 + lane; const f32x4* xr1 = (const f32x4*)x1 + lane; const f32x4* wr4 = (const f32x4*)w + lane;
    f32x4 a[8], b[8]; float s0 = 0.f, s1 = 0.f;
#pragma unroll
    for (int j = 0; j < 8; ++j) { a[j] = xr0[64 * j]; b[j] = xr1[64 * j]; }
#pragma unroll
    for (int j = 0; j < 8; ++j) { s0 += (a[j].x * a[j].x + a[j].y * a[j].y) + (a[j].z * a[j].z + a[j].w * a[j].w); s1 += (b[j].x * b[j].x + b[j].y * b[j].y) + (b[j].z * b[j].z + b[j].w * b[j].w); }
    const float r0 = rsqrtf(wave_sum(s0) * (1.f / D) + EPS), r1 = rsqrtf(wave_sum(s1) * (1.f / D) + EPS);
    u32x2* p0 = (u32x2*)o0 + lane; u32x2* p1 = (u32x2*)o1 + lane;
#pragma unroll
    for (int j = 0; j < 8; ++j) { const f32x4 ww = wr4[64 * j]; u32x2 o; o.x = cvtpk(a[j].x * r0 * ww.x, a[j].y * r0 * ww.y); o.y = cvtpk(a[j].z * r0 * ww.z, a[j].w * r0 * ww.w); p0[64 * j] = o;
        u32x2 q; q.x = cvtpk(b[j].x * r1 * ww.x, b[j].y * r1 * ww.y); q.y = cvtpk(b[j].z * r1 * ww.z, b[j].w * r1 * ww.w); p1[64 * j] = q; }
}
__device__ __forceinline__ void p0_prologue(Frame& F, const Args& a) {
    const Ids I = phase_ids(F.wave);
    LAS float* scr = (LAS float*)(F.lds + I.wave * 16384);
    const int gw = F.vcu * NWAVES + I.wave, NGW = F.G * NWAVES, lane = I.lane;
    unsigned char* ws = F.ws;
    bf16_t* WIN = (bf16_t*)(ws + WS_WIN); bf16_t* WQKV = (bf16_t*)(ws + WS_WQKV2);
    constexpr int I_IN = 32 * (6208 / 32), I_UQ = 8 * (3072 / 32), I_UKV = 8 * (4096 / 32), I_O = 32 * 64, I_OUT = 32 * 64, I_RE = 32 * 2, I_WEFF = 16 * 64;
    constexpr int NITEMS = I_IN + I_UQ + I_UKV + I_O + I_OUT + I_RE + I_WEFF;
    for (int it = gw; it < NITEMS; it += NGW) {
        int r = it;
        if (r < I_IN) { p0_transpose_item<MAP_WIN>(a.in[3], 6208, WIN, 2048, 0, nullptr, scr, r, lane); continue; } r -= I_IN;
        if (r < I_UQ) { p0_transpose_item<MAP_UQ>(a.in[5], 3072, WQKV, 2048, 0, a.in[4], scr, r, lane); continue; } r -= I_UQ;
        if (r < I_UKV) { p0_transpose_item<MAP_ID>(a.in[7], 4096, WQKV, 2048, 3072, a.in[6], scr, r, lane); continue; } r -= I_UKV;
        if (r < I_O) { p0_transpose_item<MAP_ID>(a.in[8], 2048, (bf16_t*)(ws + WS_WO), 2048, 0, nullptr, scr, r, lane); continue; } r -= I_O;
        if (r < I_OUT) { p0_transpose_item<MAP_ID>(a.in[12], 2048, (bf16_t*)(ws + WS_WOUT), 2048, 0, nullptr, scr, r, lane); continue; } r -= I_OUT;
        if (r < I_RE) { p0_transpose_item<MAP_ID>(a.in[16], 64, (bf16_t*)(ws + WS_WR), 2048, 8, nullptr, scr, r, lane); continue; } r -= I_RE;
        p0_transpose_item<MAP_ID>(a.in[11], 2048, (bf16_t*)(ws + WS_WPOT), 1024, 0, a.in[10], scr, r, lane);
    }
    { const int gt = gw * 64 + lane, NT = NGW * 64; bf16_t* WR = (bf16_t*)(ws + WS_WR);
      for (int i = gt; i < 8 * 2048; i += NT) { const int n = i >> 11, k = i & 2047; WR[(size_t)n * 2048 + k] = f2bf(a.in[14][(size_t)k * 8 + n]); }
      for (int i = gt; i < (128 - 72) * 2048; i += NT) WR[(size_t)72 * 2048 + i] = 0;
      { bf16_t* PWB = (bf16_t*)(ws + WS_PWB); for (int i = gt; i < 4 * 256 * 256 / 4; i += NT) { const f32x4 v = *(const f32x4*)(a.in[9] + (size_t)i * 4); u32x2 o; o.x = cvtpk(v[0], v[1]); o.y = cvtpk(v[2], v[3]); *(u32x2*)(PWB + (size_t)i * 4) = o; } }
      u32x4* z = (u32x4*)(WIN + (size_t)6208 * 2048);
      for (int i = gt; i < (WIN_ROWS - 6208) * 2048 * 2 / 16; i += NT) z[i] = (u32x4){0u, 0u, 0u, 0u};
      bf16_t* Kb = (bf16_t*)(ws + WS_K); bf16_t* Vb = (bf16_t*)(ws + WS_V);
      for (int i = gt; i < NH * 48 * QKD / 8; i += NT) { const int h = i / (48 * QKD / 8), r = i % (48 * QKD / 8); *(u32x4*)(Kb + ((size_t)h * KROWS + 8208) * QKD + (size_t)r * 8) = (u32x4){0u, 0u, 0u, 0u}; }
      for (int i = gt; i < NH * 48 * VD / 8; i += NT) { const int h = i / (48 * VD / 8), r = i % (48 * VD / 8); *(u32x4*)(Vb + ((size_t)h * KROWS + 8208) * VD + (size_t)r * 8) = (u32x4){0u, 0u, 0u, 0u}; }
      f32x2* RT = (f32x2*)(ws + WS_ROPE);
      for (int i = gt; i < LTOT * 32; i += NT) { const int pos = i >> 5, ii = i & 31; float s, c; sincosf((float)pos * (1.0f / powf(10000.f, (float)(2 * ii) / 64.f)), &s, &c); RT[i] = (f32x2){c, s}; }
    }
    for (int m = gw; m < SEQ + NMETA; m += NGW) {
        if (m < SEQ) rms_row_to_bf16(a.in[0] + (size_t)m * D, a.in[2], (bf16_t*)(ws + WS_XN) + (size_t)m * D, lane);
        else rms_row_to_bf16(a.in[1] + (size_t)(m - SEQ) * D, a.in[2], (bf16_t*)(ws + WS_XNM) + (size_t)(m - SEQ) * D, lane);
    }
}

__device__ __forceinline__ void meta_stage1(Frame& F) {
    const Ids I = phase_ids(F.wave);
    const int item = blockIdx.x * NWAVES + I.wave; if (item >= 100) return;
    unsigned char* ws = F.ws; const int lane = I.lane, c16 = lane & 15, q4 = lane >> 4;
    const int nb = item < 32 ? 512 + 16 * item : (item < 96 ? 1024 + 16 * (item - 32) : 6144 + 16 * (item - 96));
    const bf16_t* Ap = (const bf16_t*)(ws + WS_XNM) + (size_t)c16 * D + 8 * q4;
    const bf16_t* Bp = (const bf16_t*)(ws + WS_WIN) + (size_t)(nb + c16) * D + 8 * q4;
    f32x4 acc = {0.f, 0.f, 0.f, 0.f};
#pragma unroll 16
    for (int ks = 0; ks < 64; ++ks) { const bf16x8 av = *(const bf16x8*)(Ap + 32 * ks), bv = *(const bf16x8*)(Bp + 32 * ks); acc = __builtin_amdgcn_mfma_f32_16x16x32_bf16(av, bv, acc, 0, 0, 0); }
    if (item < 32) { float* CK = (float*)(ws + WS_XNM + 65536);
#pragma unroll
        for (int r = 0; r < 4; ++r) CK[(4 * q4 + r) * 512 + 16 * item + c16] = acc[r]; }
    else if (item < 96) { bf16_t* U = (bf16_t*)(ws + WS_U);
#pragma unroll
        for (int r = 0; r < 4; ++r) U[(size_t)(4 * q4 + r) * 1024 + 16 * (item - 32) + c16] = f2bf(acc[r]); }
    else { const int col = 16 * (item - 96) + c16, ii = col >> 1; const f32x2* RT = (const f32x2*)(ws + WS_ROPE); bf16_t* Kb = (bf16_t*)(ws + WS_K);
#pragma unroll
        for (int r = 0; r < 4; ++r) { const int row = 4 * q4 + r; const float own = acc[r], oth = __shfl_xor(own, 1); const f32x2 cs = RT[row * 32 + ii];
            const float y = (col & 1) ? (oth * cs.y + own * cs.x) : (own * cs.x - oth * cs.y); const bf16_t yb = f2bf(y);
            for (int h = 0; h < NH; ++h) Kb[((size_t)h * KROWS + SEQ + row) * QKD + 128 + col] = yb; } }
}


__device__ __forceinline__ void weff_stage(Frame& F) {
    const Ids I = phase_ids(F.wave); unsigned char* ws = F.ws; const int lane = I.lane, c16 = lane & 15, q4 = lane >> 4;
    const bf16_t* PWB = (const bf16_t*)(ws + WS_PWB); const bf16_t* WPOT = (const bf16_t*)(ws + WS_WPOT); bf16_t* WPE = (bf16_t*)(ws + WS_WPE);
    for (int item = F.vcu * NWAVES + I.wave; item < 4 * 16 * 128; item += F.G * NWAVES) { const int nb = item & 127, cb = (item >> 7) & 15, g = item >> 11;
        const bf16_t* Ap = PWB + ((size_t)g * 256 + cb * 16 + c16) * 256 + 8 * q4;
        const bf16_t* Bp = WPOT + (size_t)(nb * 16 + c16) * 1024 + g * 256 + 8 * q4;
        f32x4 acc = {0.f, 0.f, 0.f, 0.f};
#pragma unroll
        for (int ks = 0; ks < 8; ++ks) { const bf16x8 av = *(const bf16x8*)(Ap + 32 * ks), bv = *(const bf16x8*)(Bp + 32 * ks); acc = __builtin_amdgcn_mfma_f32_16x16x32_bf16(av, bv, acc, 0, 0, 0); }
        u32x2 o; o.x = cvtpk(acc[0], acc[1]); o.y = cvtpk(acc[2], acc[3]);
        *(u32x2*)(WPE + (size_t)(nb * 16 + c16) * 2048 + g * 256 + cb * 16 + 4 * q4) = o; }
}
struct SchedP1 { pg8::TileOrder T; const char* A; const char* B;
    __device__ __forceinline__ bool next(int i, pg8::GUnit& u) const { int pm, pn; if (!T.tile(i, pm, pn)) return false; u.pm = pm; u.pn = pn; u.aux = 0; u.nt = 32; u.A = A + (size_t)pm * 256 * 4096; u.B = B + (size_t)pn * 256 * 4096; return true; } };
struct EpiP1 {
    bf16_t* CQKV; float* SSQ; bf16_t* U; bf16_t* G; bf16_t* Kb; const f32x2* RT;
    __device__ __forceinline__ int nstores(const pg8::GUnit&) const { return 16; }
    __device__ __forceinline__ void operator()(const f32x4 (&acc)[2][2][4][2], const pg8::GUnit& u, int wr, int wc, int fr, int fq) const {
        const int pn = u.pn, row0 = u.pm * 256 + wr * 64 + fr;
        if (pn < 4) {
#pragma unroll
            for (int ai = 0; ai < 2; ++ai)
#pragma unroll
                for (int m = 0; m < 4; ++m) { const int r = row0 + ai * 128 + m * 16;
#pragma unroll
                    for (int bj = 0; bj < 2; ++bj) { const f32x4 v0 = acc[ai][bj][m][0], v1 = acc[ai][bj][m][1];
                        u32x4 w; w.x = cvtpk(v0[0], v0[1]); w.y = cvtpk(v0[2], v0[3]); w.z = cvtpk(v1[0], v1[1]); w.w = cvtpk(v1[2], v1[3]);
                        *(u32x4*)(CQKV + (size_t)r * 2048 + pn * 256 + bj * 128 + wc * 32 + 8 * fq) = w;
                        float s = (v0[0] * v0[0] + v0[1] * v0[1]) + (v0[2] * v0[2] + v0[3] * v0[3]) + (v1[0] * v1[0] + v1[1] * v1[1]) + (v1[2] * v1[2] + v1[3] * v1[3]);
                        s += __shfl_xor(s, 16); s += __shfl_xor(s, 32);
                        if (fq == 0) SSQ[((size_t)(pn >> 1) * SEQ + r) * 16 + (pn & 1) * 8 + bj * 4 + wc] = s; } }
        } else if (pn < 8) {
#pragma unroll
            for (int ai = 0; ai < 2; ++ai)
#pragma unroll
                for (int m = 0; m < 4; ++m) { const int r = row0 + ai * 128 + m * 16;
#pragma unroll
                    for (int bj = 0; bj < 2; ++bj) { const f32x4 v0 = acc[ai][bj][m][0], v1 = acc[ai][bj][m][1];
                        u32x4 w; w.x = cvtpk(v0[0], v0[1]); w.y = cvtpk(v0[2], v0[3]); w.z = cvtpk(v1[0], v1[1]); w.w = cvtpk(v1[2], v1[3]);
                        *(u32x4*)(U + (size_t)(NMETA + r) * 1024 + (pn - 4) * 256 + bj * 128 + wc * 32 + 8 * fq) = w; } }
        } else {
#pragma unroll
            for (int ai = 0; ai < 2; ++ai)
#pragma unroll
                for (int m = 0; m < 4; ++m) { const int r = row0 + ai * 128 + m * 16;
#pragma unroll
                    for (int bj = 0; bj < 2; ++bj) { const f32x4 v0 = acc[ai][bj][m][0], v1 = acc[ai][bj][m][1];
                        u32x4 w; w.x = cvtpk(sigmoidf_(v0[0]), sigmoidf_(v0[1])); w.y = cvtpk(sigmoidf_(v0[2]), sigmoidf_(v0[3])); w.z = cvtpk(sigmoidf_(v1[0]), sigmoidf_(v1[1])); w.w = cvtpk(sigmoidf_(v1[2]), sigmoidf_(v1[3]));
                        *(u32x4*)(G + (size_t)r * 4096 + (pn - 8) * 256 + bj * 128 + wc * 32 + 8 * fq) = w; } }
        }
    }
};


template <int W> __device__ __forceinline__ void pool_strip(const bf16_t* U, bf16_t* PL, int p0, int c0) {
    u32x4 v[W + 7];
#pragma unroll
    for (int j = 0; j < W + 7; ++j) v[j] = *(const u32x4*)(U + (size_t)(p0 - W + 1 + j) * 1024 + c0);
    float sum[8];
#pragma unroll
    for (int e = 0; e < 8; ++e) sum[e] = 0.f;
#pragma unroll
    for (int j = 0; j < W - 1; ++j) { sum[0] += bflo(v[j].x); sum[1] += bfhi(v[j].x); sum[2] += bflo(v[j].y); sum[3] += bfhi(v[j].y); sum[4] += bflo(v[j].z); sum[5] += bfhi(v[j].z); sum[6] += bflo(v[j].w); sum[7] += bfhi(v[j].w); }
    constexpr float iw = 1.f / (float)W;
#pragma unroll
    for (int i = 0; i < 8; ++i) { const u32x4 x_ = v[W - 1 + i];
        const float x0 = bflo(x_.x), x1 = bfhi(x_.x), x2 = bflo(x_.y), x3 = bfhi(x_.y), x4 = bflo(x_.z), x5 = bfhi(x_.z), x6 = bflo(x_.w), x7 = bfhi(x_.w);
        sum[0] += x0; sum[1] += x1; sum[2] += x2; sum[3] += x3; sum[4] += x4; sum[5] += x5; sum[6] += x6; sum[7] += x7;
        u32x4 o; o.x = cvtpk(sum[0] * iw - x0, sum[1] * iw - x1); o.y = cvtpk(sum[2] * iw - x2, sum[3] * iw - x3); o.z = cvtpk(sum[4] * iw - x4, sum[5] * iw - x5); o.w = cvtpk(sum[6] * iw - x6, sum[7] * iw - x7);
        *(u32x4*)(PL + (size_t)(p0 + i - NMETA) * 2048 + c0) = o;
        const u32x4 q = v[i];
        sum[0] -= bflo(q.x); sum[1] -= bfhi(q.x); sum[2] -= bflo(q.y); sum[3] -= bfhi(q.y); sum[4] -= bflo(q.z); sum[5] -= bfhi(q.z); sum[6] -= bflo(q.w); sum[7] -= bfhi(q.w); }
}
__device__ __forceinline__ void pool_phase(Frame& F) {
    const Ids I = phase_ids(F.wave);
    const bf16_t* U = (const bf16_t*)(F.ws + WS_U); bf16_t* PL = (bf16_t*)(F.ws + WS_PL);
    const int gt = (F.vcu * NWAVES + I.wave) * 64 + I.lane, NT = F.G * NTHR;
    for (int item = gt; item < 1024 * 128; item += NT) {
        const int cc = item & 127, strip = item >> 7, c0 = cc * 8, g = c0 >> 8, p0 = NMETA + strip * 8;
        if (g == 0) pool_strip<2>(U, PL, p0, c0); else if (g == 1) pool_strip<4>(U, PL, p0, c0); else if (g == 2) pool_strip<8>(U, PL, p0, c0); else pool_strip<16>(U, PL, p0, c0);
    }
}
__device__ __forceinline__ void meta_stage2(Frame& F) {
    const Ids I = phase_ids(F.wave);
    const int bx_ = (int)blockIdx.x; int item;
    if (F.G == 256) { if ((bx_ & 7) != ((bx_ >> 3) & 7)) return; item = (bx_ >> 3) * NWAVES + I.wave; } else { item = bx_ * NWAVES + I.wave; if (item >= 256) return; }
    unsigned char* ws = F.ws; const int lane = I.lane, c16 = lane & 15, q4 = lane >> 4;
    const float* CK = (const float*)(ws + WS_XNM + 65536) + (size_t)c16 * 512;
    float ss = 0.f;
    for (int k = 0; k < 128; k += 4) { const f32x4 v = *(const f32x4*)(CK + q4 * 128 + k); ss += (v[0] * v[0] + v[1] * v[1]) + (v[2] * v[2] + v[3] * v[3]); }
    ss += __shfl_xor(ss, 16); ss += __shfl_xor(ss, 32);
    const float rstd_own = rsqrtf(ss * (1.f / 512.f) + EPS);
    const bf16_t* Bp = (const bf16_t*)(ws + WS_WQKV2) + (size_t)(3072 + 16 * item + c16) * 2048 + 8 * q4;
    f32x4 acc = {0.f, 0.f, 0.f, 0.f};
#pragma unroll 4
    for (int ks = 0; ks < 16; ++ks) { const f32x4 a0 = *(const f32x4*)(CK + 32 * ks + 8 * q4), a1 = *(const f32x4*)(CK + 32 * ks + 8 * q4 + 4);
        u32x4 aw; aw.x = cvtpk(a0[0], a0[1]); aw.y = cvtpk(a0[2], a0[3]); aw.z = cvtpk(a1[0], a1[1]); aw.w = cvtpk(a1[2], a1[3]);
        const bf16x8 bv = *(const bf16x8*)(Bp + 32 * ks); acc = __builtin_amdgcn_mfma_f32_16x16x32_bf16(__builtin_bit_cast(bf16x8, aw), bv, acc, 0, 0, 0); }
    const int cc = 16 * item + c16, h = cc >> 8, d = cc & 255;
    bf16_t* Kb = (bf16_t*)(ws + WS_K); bf16_t* Vb = (bf16_t*)(ws + WS_V);
#pragma unroll
    for (int r = 0; r < 4; ++r) { const int row = 4 * q4 + r; const float rs = __shfl(rstd_own, row); const bf16_t y = f2bf(acc[r] * rs);
        if (d < 128) Kb[((size_t)h * KROWS + SEQ + row) * QKD + d] = y; else Vb[((size_t)h * KROWS + SEQ + row) * VD + d - 128] = y; }
}
constexpr float QSCALE = 0.07216878364870323f * 1.4426950408889634f;
struct SchedP2 { pg8::TileOrder T; const char* A; const char* B; const char* XN; const char* WKR; int nh, hfirst, hstep, only_heavy;
    __device__ __forceinline__ void init(int G, int b, const char* A_, const char* B_, const char* XN_, const char* WKR_) { A = A_; B = B_; XN = XN_; WKR = WKR_;
        if (G == 256) { const int heavy = ((b & 7) == ((b >> 3) & 7)); nh = heavy; hfirst = b >> 3; hstep = 32; only_heavy = heavy;
            const int nb = (b >> 3) + (((b & 7) > ((b >> 3) & 7)) ? 1 : 0); T.init(32, 28, G - 32, b - nb); }
        else { nh = b < 32 ? (31 - b) / G + 1 : 0; hfirst = b; hstep = G; only_heavy = 0; T.init(32, 28, G, b); } }
    __device__ __forceinline__ bool next(int i, pg8::GUnit& u) const {
        if (i < nh) { const int pm = hfirst + i * hstep; u.pm = pm; u.pn = 28; u.aux = 0; u.nt = 32; u.A = XN + (size_t)pm * 256 * 4096; u.B = WKR; return true; }
        if (only_heavy) return false;
        int pm, pn; if (!T.tile(i - nh, pm, pn)) return false; u.pm = pm; u.pn = pn; u.aux = (i - nh) & 3; u.nt = 8;
        u.A = A + (size_t)pm * 256 * 4096 + (pn >= 12 ? 1024 : 0); u.B = B + (size_t)pn * 256 * 4096; return true; } };
struct EpiP2 {
    bf16_t* Q; bf16_t* Kb; bf16_t* Vb; const f32x2* RT; const LAS float* rtab;
    int abl = 0;
    __device__ __forceinline__ int nstores(const pg8::GUnit& u) const { return (abl || u.pn == 28) ? 0 : 16; }
#ifdef MK_P2ABL
#define P2_ST(p_, v_) do { if (abl & 2) asm volatile("" :: "v"(v_)); else *(u32x4*)(p_) = (v_); } while (0)
#else
#ifdef MK_NTST
#define P2_ST(p_, v_) do { __builtin_nontemporal_store((v_), (u32x4*)(p_)); } while (0)
#else
#define P2_ST(p_, v_) do { *(u32x4*)(p_) = (v_); } while (0)
#endif
#endif
    __device__ __forceinline__ void operator()(const f32x4 (&acc)[2][2][4][2], const pg8::GUnit& u, int wr, int wc, int fr, int fq) const {
        if (abl & 1) { asm volatile("" :: "v"(acc[0][0][0][0]), "v"(acc[1][1][3][1])); return; }
        const int pn = u.pn, rl0 = wr * 64 + fr, row0 = u.pm * 256 + rl0;
        const LAS float* rt = rtab + u.aux * 256;
#define P2_ROT(w, v0, v1, cs0, cs1) do { w.x = cvtpk(v0[0] * cs0[0] - v0[1] * cs0[1], v0[0] * cs0[1] + v0[1] * cs0[0]); w.y = cvtpk(v0[2] * cs0[2] - v0[3] * cs0[3], v0[2] * cs0[3] + v0[3] * cs0[2]); \
            w.z = cvtpk(v1[0] * cs1[0] - v1[1] * cs1[1], v1[0] * cs1[1] + v1[1] * cs1[0]); w.w = cvtpk(v1[2] * cs1[2] - v1[3] * cs1[3], v1[2] * cs1[3] + v1[3] * cs1[2]); } while (0)
        if (pn == 28) {
            if (wc < 2) { const int colr = wc * 32 + 8 * fq, i0 = colr >> 1;
                f32x4 cs[2][4][2];
#pragma unroll
                for (int ai = 0; ai < 2; ++ai)
#pragma unroll
                    for (int m = 0; m < 4; ++m) { const int r = row0 + ai * 128 + m * 16; cs[ai][m][0] = *(const f32x4*)(RT + (size_t)(r + NMETA) * 32 + i0); cs[ai][m][1] = *(const f32x4*)(RT + (size_t)(r + NMETA) * 32 + i0 + 2); }
#pragma unroll
                for (int ai = 0; ai < 2; ++ai)
#pragma unroll
                    for (int m = 0; m < 4; ++m) { const int r = row0 + ai * 128 + m * 16; const f32x4 v0 = acc[ai][0][m][0], v1 = acc[ai][0][m][1];
                        u32x4 w; P2_ROT(w, v0, v1, cs[ai][m][0], cs[ai][m][1]);
#pragma unroll
                        for (int h = 0; h < NH; ++h) P2_ST(Kb + ((size_t)h * KROWS + r) * QKD + 128 + colr, w); } }
        } else if (pn < 12) {
            const int cu = pn * 256 + wc * 32, c0 = cu + 8 * fq, d0 = cu % 192, d1 = (cu + 128) % 192;
            const int bjr = __builtin_amdgcn_readfirstlane(d0 >= 128 ? 0 : (d1 >= 128 ? 1 : -1));
            if (bjr >= 0) {
                const int c = c0 + bjr * 128, h = c / 192, d = c - h * 192, i0 = (d - 128) >> 1;
                const int hu = __builtin_amdgcn_readfirstlane((cu + bjr * 128) / 192), rowu = u.pm * 256 + wr * 64;
                const char* qbu = (const char*)(Q + ((size_t)hu * SEQ + rowu) * QKD); const unsigned qlo = (unsigned)((fr * QKD + d) * 2);
                const char* rtu = (const char*)(RT + (size_t)(rowu + NMETA) * 32); const unsigned rlo = (unsigned)((fr * 32 + i0) * 8);
                (void)h;
                f32x4 csA[4][2], csB[4][2]; u32x4 wq[4];
#define P2_RLOAD(ai, cs_) do { _Pragma("unroll") for (int m = 0; m < 4; ++m) { const int ro = (ai) * 128 + m * 16; cs_[m][0] = *(const f32x4*)(rtu + (size_t)ro * 256 + rlo); cs_[m][1] = *(const f32x4*)(rtu + (size_t)ro * 256 + rlo + 16); } } while (0)
#define P2_RCALC(ai, cs_) do { _Pragma("unroll") for (int m = 0; m < 4; ++m) { const float sc = rt[rl0 + (ai) * 128 + m * 16] * QSCALE; \
                    const f32x4 a0 = bjr ? acc[ai][1][m][0] : acc[ai][0][m][0], a1 = bjr ? acc[ai][1][m][1] : acc[ai][0][m][1]; const f32x4 v0 = a0 * sc, v1 = a1 * sc; \
                    u32x4 w; P2_ROT(w, v0, v1, cs_[m][0], cs_[m][1]); wq[m] = w; } } while (0)
#define P2_RSTORE(ai) do { _Pragma("unroll") for (int m = 0; m < 4; ++m) P2_ST(qbu + (size_t)((ai) * 128 + m * 16) * (QKD * 2) + qlo, wq[m]); } while (0)
                P2_RLOAD(0, csA); P2_RCALC(0, csA); P2_RLOAD(1, csB); P2_RSTORE(0); P2_RCALC(1, csB); P2_RSTORE(1);
#undef P2_RLOAD
#undef P2_RCALC
#undef P2_RSTORE
            }
#pragma unroll
            for (int bj = 0; bj < 2; ++bj) if (bj != bjr) { const int c = c0 + bj * 128, h = c / 192, d = c - h * 192;
                bf16_t* qb = Q + (size_t)h * SEQ * QKD + d;
#pragma unroll
                for (int ai = 0; ai < 2; ++ai)
#pragma unroll
                    for (int m = 0; m < 4; ++m) { const int rl = rl0 + ai * 128 + m * 16; const float sc = rt[rl] * QSCALE; const f32x4 v0 = acc[ai][bj][m][0] * sc, v1 = acc[ai][bj][m][1] * sc;
                        u32x4 w; w.x = cvtpk(v0[0], v0[1]); w.y = cvtpk(v0[2], v0[3]); w.z = cvtpk(v1[0], v1[1]); w.w = cvtpk(v1[2], v1[3]);
                        P2_ST(qb + (size_t)(u.pm * 256 + rl) * QKD, w); } }
        } else { const int h = pn - 12, dc = wc * 32 + 8 * fq;
#pragma unroll
            for (int ai = 0; ai < 2; ++ai)
#pragma unroll
                for (int m = 0; m < 4; ++m) { const int rl = rl0 + ai * 128 + m * 16, r = u.pm * 256 + rl; const float sc = rt[rl];
#pragma unroll
                    for (int bj = 0; bj < 2; ++bj) { const f32x4 v0 = acc[ai][bj][m][0] * sc, v1 = acc[ai][bj][m][1] * sc;
                        u32x4 w; w.x = cvtpk(v0[0], v0[1]); w.y = cvtpk(v0[2], v0[3]); w.z = cvtpk(v1[0], v1[1]); w.w = cvtpk(v1[2], v1[3]);
                        if (bj == 0) P2_ST(Kb + ((size_t)h * KROWS + r) * QKD + dc, w); else P2_ST(Vb + ((size_t)h * KROWS + r) * VD + dc, w); } }
        }
#undef P2_ROT
#undef P2_ST
        (void)row0;
    }
};


constexpr size_t WS_T1 = WS_K;
constexpr size_t WS_MG = WS_Q;
constexpr size_t WS_H1 = WS_G;
constexpr size_t WS_H1B = WS_XN;
constexpr size_t WS_H1S = WS_O;
struct SchedP4 { pg8::TileOrder T; const char* A0; const char* B0; const char* A1; const char* B1;
    __device__ __forceinline__ bool next(int i, pg8::GUnit& u) const { int pm, pn; if (!T.tile(i >> 1, pm, pn)) return false; u.pm = pm; u.pn = pn; u.aux = i & 1; u.nt = (i & 1) ? 16 : 32;
        u.A = ((i & 1) ? A1 : A0) + (size_t)pm * 256 * 4096; u.B = ((i & 1) ? B1 : B0) + (size_t)pn * 256 * 4096; return true; } };
struct EpiP4 {
    const bf16_t* G; bf16_t* MG;
    static constexpr float GMIN = 1e-20f;
    __device__ __forceinline__ bool carry(const pg8::GUnit& u) const { return u.aux == 0; }
    __device__ __forceinline__ void rescale(f32x4 (&acc)[2][2][4][2], const pg8::GUnit& u, int wr, int wc, int fr, int fq) const {
        const int row0 = u.pm * 256 + wr * 64 + fr, col0 = u.pn * 256 + wc * 32 + 8 * fq;
        const bf16_t* gp = G + (size_t)row0 * 4096 + col0;
#pragma unroll
        for (int ai = 0; ai < 2; ++ai) { u32x4 g1[4][2], g2[4][2];
#pragma unroll
            for (int m = 0; m < 4; ++m)
#pragma unroll
                for (int bj = 0; bj < 2; ++bj) { const bf16_t* q = gp + (size_t)(ai * 128 + m * 16) * 4096 + bj * 128; g1[m][bj] = *(const u32x4*)q; g2[m][bj] = *(const u32x4*)(q + 2048); }
#pragma unroll
            for (int m = 0; m < 4; ++m)
#pragma unroll
                for (int bj = 0; bj < 2; ++bj) { const u32x4 a = g1[m][bj], b = g2[m][bj];
#define P4_R(x, y) ((x) * __builtin_amdgcn_rcpf(fmaxf((y), GMIN)))
                    const f32x4 r0 = {P4_R(bflo(a.x), bflo(b.x)), P4_R(bfhi(a.x), bfhi(b.x)), P4_R(bflo(a.y), bflo(b.y)), P4_R(bfhi(a.y), bfhi(b.y))};
                    const f32x4 r1 = {P4_R(bflo(a.z), bflo(b.z)), P4_R(bfhi(a.z), bfhi(b.z)), P4_R(bflo(a.w), bflo(b.w)), P4_R(bfhi(a.w), bfhi(b.w))};
#undef P4_R
                    acc[ai][bj][m][0] *= r0; acc[ai][bj][m][1] *= r1; } }
    }
    __device__ __forceinline__ void operator()(const f32x4 (&acc)[2][2][4][2], const pg8::GUnit& u, int wr, int wc, int fr, int fq) const {
        const int row0 = u.pm * 256 + wr * 64 + fr, col0 = u.pn * 256 + wc * 32 + 8 * fq;
        const bf16_t* gp = G + (size_t)row0 * 4096 + 2048 + col0; bf16_t* op = MG + (size_t)row0 * 2048 + col0;
        u32x4 g2[2][4][2];
#pragma unroll
        for (int ai = 0; ai < 2; ++ai)
#pragma unroll
            for (int m = 0; m < 4; ++m)
#pragma unroll
                for (int bj = 0; bj < 2; ++bj) g2[ai][m][bj] = *(const u32x4*)(gp + (size_t)(ai * 128 + m * 16) * 4096 + bj * 128);
#pragma unroll
        for (int ai = 0; ai < 2; ++ai)
#pragma unroll
            for (int m = 0; m < 4; ++m)
#pragma unroll
                for (int bj = 0; bj < 2; ++bj) { const u32x4 g = g2[ai][m][bj]; const f32x4 v0 = acc[ai][bj][m][0], v1 = acc[ai][bj][m][1];
                    u32x4 w; w.x = cvtpk(fmaxf(bflo(g.x), GMIN) * v0[0], fmaxf(bfhi(g.x), GMIN) * v0[1]); w.y = cvtpk(fmaxf(bflo(g.y), GMIN) * v0[2], fmaxf(bfhi(g.y), GMIN) * v0[3]);
                    w.z = cvtpk(fmaxf(bflo(g.z), GMIN) * v1[0], fmaxf(bfhi(g.z), GMIN) * v1[1]); w.w = cvtpk(fmaxf(bflo(g.w), GMIN) * v1[2], fmaxf(bfhi(g.w), GMIN) * v1[3]);
                    *(u32x4*)(op + (size_t)(ai * 128 + m * 16) * 2048 + bj * 128) = w; }
    }
};
struct SchedP5 { pg8::TileOrder T; const char* A; const char* B;
    __device__ __forceinline__ bool next(int i, pg8::GUnit& u) const { int pm, pn; if (!T.tile(i, pm, pn)) return false; u.pm = pm; u.pn = pn; u.aux = 0; u.nt = 32; u.A = A + (size_t)pm * 256 * 4096; u.B = B + (size_t)pn * 256 * 4096; return true; } };
struct EpiP5 {
    const float* X; float* H1; bf16_t* H1B; float* SS2; bf16_t* H1S; const float* WF;
    __device__ __forceinline__ void init(f32x4 (&acc)[2][2][4][2], const pg8::GUnit& u, int wr, int wc, int fr, int fq) const {
        const int row0 = u.pm * 256 + wr * 64 + fr, col0 = u.pn * 256 + wc * 32 + 8 * fq;
#pragma unroll
        for (int ai = 0; ai < 2; ++ai)
#pragma unroll
            for (int m = 0; m < 4; ++m)
#pragma unroll
                for (int bj = 0; bj < 2; ++bj) { const size_t off = (size_t)(row0 + ai * 128 + m * 16) * 2048 + col0 + bj * 128;
                    acc[ai][bj][m][0] = *(const f32x4*)(X + off); acc[ai][bj][m][1] = *(const f32x4*)(X + off + 4); }
    }
    __device__ __forceinline__ void operator()(const f32x4 (&acc)[2][2][4][2], const pg8::GUnit& u, int wr, int wc, int fr, int fq) const {
        const int row0 = u.pm * 256 + wr * 64 + fr, col0 = u.pn * 256 + wc * 32 + 8 * fq;
        f32x4 wf[2][2];
#pragma unroll
        for (int bj = 0; bj < 2; ++bj) { wf[bj][0] = *(const f32x4*)(WF + col0 + bj * 128); wf[bj][1] = *(const f32x4*)(WF + col0 + bj * 128 + 4); }
#pragma unroll
        for (int ai = 0; ai < 2; ++ai)
#pragma unroll
            for (int m = 0; m < 4; ++m) { const int r = row0 + ai * 128 + m * 16;
#pragma unroll
                for (int bj = 0; bj < 2; ++bj) { const int c = col0 + bj * 128; const size_t off = (size_t)r * 2048 + c;
                    const f32x4 t0 = acc[ai][bj][m][0], t1 = acc[ai][bj][m][1];
                    u32x4 w; w.x = cvtpk(t0[0], t0[1]); w.y = cvtpk(t0[2], t0[3]); w.z = cvtpk(t1[0], t1[1]); w.w = cvtpk(t1[2], t1[3]);
                    *(u32x4*)(H1B + off) = w;
                    { const f32x4 f0 = wf[bj][0], f1 = wf[bj][1]; u32x4 ws_; ws_.x = cvtpk(t0[0] * f0[0], t0[1] * f0[1]); ws_.y = cvtpk(t0[2] * f0[2], t0[3] * f0[3]); ws_.z = cvtpk(t1[0] * f1[0], t1[1] * f1[1]); ws_.w = cvtpk(t1[2] * f1[2], t1[3] * f1[3]);
                      *(u32x4*)(H1S + off) = ws_; }
                    float sq = (t0[0] * t0[0] + t0[1] * t0[1]) + (t0[2] * t0[2] + t0[3] * t0[3]) + (t1[0] * t1[0] + t1[1] * t1[1]) + (t1[2] * t1[2] + t1[3] * t1[3]);
                    sq += __shfl_xor(sq, 16); sq += __shfl_xor(sq, 32);
                    if (fq == 0) SS2[(size_t)r * 64 + u.pn * 8 + bj * 4 + wc] = sq; } }
    }
};


constexpr size_t RT_EID = WS_RT, RT_WGT = WS_RT + 65536, RT_RS2 = WS_RT + 131072, RT_CNTB = WS_RT + 196608, RT_OFF = WS_RT + 262144  ,
                 RT_STOK = WS_RT + 327680, RT_SW = WS_RT + 458752, RT_SRS = WS_RT + 589824, RT_SDST = WS_RT + 720896;
constexpr size_t WS_HDN = WS_CQKV;
constexpr size_t WS_Y = WS_K;
__device__ __forceinline__ void router_phase(Frame& F, const Args& a, const int abl = 0) {
    const Ids I = phase_ids(F.wave); const int tid = I.tid;
    unsigned char* ws = F.ws; const int lane = I.lane, c16 = lane & 15, q4 = lane >> 4, wave = I.wave;
    LAS float* red = (LAS float*)F.lds;
    LAS int* hist = (LAS int*)(F.lds + 8 * 32 * 80 * 4);
    for (int blk = blockIdx.x; blk < SEQ / 32; blk += F.G) {
        const int row0 = blk * 32;
        const bf16_t* Ap = (const bf16_t*)(ws + WS_H1S) + (size_t)(row0 + c16) * D + wave * 256 + 8 * q4;
        const bf16_t* Bp = (const bf16_t*)(ws + WS_WR) + (size_t)c16 * D + wave * 256 + 8 * q4;
        f32x4 acc[2][5];
#pragma unroll
        for (int r = 0; r < 2; ++r)
#pragma unroll
            for (int j = 0; j < 5; ++j) acc[r][j] = (f32x4){0.f, 0.f, 0.f, 0.f};
        if (!(abl & 1))
#pragma unroll 4
        for (int ks = 0; ks < 8; ++ks) { const bf16x8 av0 = *(const bf16x8*)(Ap + 32 * ks), av1 = *(const bf16x8*)(Ap + (size_t)16 * D + 32 * ks);
#pragma unroll
            for (int j = 0; j < 5; ++j) { const bf16x8 bv = *(const bf16x8*)(Bp + (size_t)j * 16 * D + 32 * ks);
                acc[0][j] = __builtin_amdgcn_mfma_f32_16x16x32_bf16(av0, bv, acc[0][j], 0, 0, 0); acc[1][j] = __builtin_amdgcn_mfma_f32_16x16x32_bf16(av1, bv, acc[1][j], 0, 0, 0); } }
        if (tid < 64) hist[tid] = 0;
#pragma unroll
        for (int rb = 0; rb < 2; ++rb)
#pragma unroll
            for (int j = 0; j < 5; ++j)
#pragma unroll
                for (int r = 0; r < 4; ++r) red[(wave * 32 + rb * 16 + 4 * q4 + r) * 80 + 16 * j + c16] = acc[rb][j][r];
        __syncthreads();
        if (tid < 32 && !(abl & 2)) { const int t = row0 + tid;
            const f32x4* sp = (const f32x4*)((const float*)(ws + WS_SS2) + (size_t)t * 64); float ssum = 0.f;
#pragma unroll
            for (int j = 0; j < 16; ++j) { const f32x4 v = sp[j]; ssum += (v[0] + v[1]) + (v[2] + v[3]); }
            const float rstd = rsqrtf(ssum * (1.f / D) + EPS);
            const LAS float* rp = red + tid * 80;
#define RSUM(c_) (((rp[c_] + rp[32 * 80 + (c_)]) + (rp[64 * 80 + (c_)] + rp[96 * 80 + (c_)])) + ((rp[128 * 80 + (c_)] + rp[160 * 80 + (c_)]) + (rp[192 * 80 + (c_)] + rp[224 * 80 + (c_)])))
            float g[8]; float gm = -1e30f; int gi = 0;
#pragma unroll
            for (int i = 0; i < 8; ++i) { g[i] = rstd * RSUM(i) + a.in[15][i]; if (g[i] > gm) { gm = g[i]; gi = i; } }
            float den = 0.f;
#pragma unroll
            for (int i = 0; i < 8; ++i) den += __expf(g[i] - gm);
            const float pg = 1.f / den;
            float e[8];
#pragma unroll
            for (int i = 0; i < 8; ++i) { const int c = 8 + gi * 8 + i; e[i] = rstd * RSUM(c) + a.in[17][gi * 8 + i]; }
#undef RSUM
            float v1 = -1e30f; int i1 = 0;
#pragma unroll
            for (int i = 0; i < 8; ++i) if (e[i] > v1) { v1 = e[i]; i1 = i; }
            float v2 = -1e30f; int i2 = 0;
#pragma unroll
            for (int i = 0; i < 8; ++i) if (i != i1 && e[i] > v2) { v2 = e[i]; i2 = i; }
            const float p2 = __expf(v2 - v1), sm = 1.f / (1.f + p2);
            int* eid = (int*)(ws + RT_EID); float* wgt = (float*)(ws + RT_WGT);
            eid[t * 2] = gi * 8 + i1; eid[t * 2 + 1] = gi * 8 + i2; wgt[t * 2] = pg * sm; wgt[t * 2 + 1] = pg * p2 * sm;
            ((float*)(ws + RT_RS2))[t] = rstd;
            atomicAdd((int*)&hist[gi * 8 + i1], 1); atomicAdd((int*)&hist[gi * 8 + i2], 1);
        }
        __syncthreads();
        if (tid < 64 && !(abl & 2)) ((int*)(ws + RT_CNTB))[blk * 64 + tid] = hist[tid];
        __syncthreads();
    }
}
__device__ __forceinline__ void slots_phase(Frame& F) {
    unsigned char* ws = F.ws; const int tid = opaque_tid(F.wave);
    LAS int* tot = (LAS int*)F.lds; LAS int* offs = tot + 64; LAS int* ent = tot + 192; LAS int* pt = tot + 256; LAS int* pb = pt + 512;
    const int* cntb = (const int*)(ws + RT_CNTB); const int* eid = (const int*)(ws + RT_EID);
    for (int blk = blockIdx.x; blk < SEQ / 32; blk += F.G) {
        { const int e = tid & 63, part = tid >> 6; int c[32];
#pragma unroll
          for (int i = 0; i < 32; ++i) c[i] = cntb[(32 * part + i) * 64 + e];
          int total = 0, before = 0;
#pragma unroll
          for (int i = 0; i < 32; ++i) { total += c[i]; if (32 * part + i < blk) before += c[i]; }
          pt[part * 64 + e] = total; pb[part * 64 + e] = before; }
        if (tid < 64) ent[tid] = eid[blk * 64 + tid];
        __syncthreads();
        int before = 0;
        if (tid < 64) { int total = 0;
#pragma unroll
            for (int p_ = 0; p_ < 8; ++p_) { total += pt[p_ * 64 + tid]; before += pb[p_ * 64 + tid]; }
            tot[tid] = total; }
        __syncthreads();
        if (tid == 0) { int acc = 0; for (int e = 0; e < 64; ++e) { offs[e] = acc; acc += tot[e]; } offs[64] = acc; }
        __syncthreads();
        if (tid < 64) { int pos = offs[tid] + before;
            int* stok = (int*)(ws + RT_STOK); float* sw = (float*)(ws + RT_SW); float* srs = (float*)(ws + RT_SRS); int* sdst = (int*)(ws + RT_SDST);
            const float* wgt = (const float*)(ws + RT_WGT); const float* rs2 = (const float*)(ws + RT_RS2);
            for (int i = 0; i < 64; ++i) if (ent[i] == tid) { const int tk = blk * 32 + (i >> 1); stok[pos] = tk; sw[pos] = wgt[blk * 64 + i]; srs[pos] = rs2[tk]; sdst[pos] = blk * 64 + i; ++pos; }
            if (blk == 0) { int* off = (int*)(ws + RT_OFF); off[tid] = offs[tid]; off[128 + tid] = tot[tid]; if (tid == 0) off[64] = offs[64]; } }
        __syncthreads();
    }
}
struct MoeTiles {
    const LAS int* tpre; const LAS int* off; const LAS int* cnt;
    __device__ __forceinline__ bool find(int tl, int& e, int& ti) const { if (tl >= tpre[64]) return false; int lo = 0; for (int k = 32; k > 0; k >>= 1) if (tpre[lo + k] <= tl) lo += k; e = lo; ti = tl - tpre[lo]; return true; }
};
__device__ __forceinline__ MoeTiles moe_tiles_build(Frame& F) {
    const int tid = opaque_tid(F.wave);
    LAS int* tp = (LAS int*)(F.lds + MISC_OFF + 5120); LAS int* of = tp + 80; LAS int* cn = tp + 160;
    const int* off = (const int*)(F.ws + RT_OFF);
    if (tid < 64) { of[tid] = off[tid]; cn[tid] = off[128 + tid]; }
    __syncthreads();
    if (tid == 0) { int acc = 0; for (int e = 0; e < 64; ++e) { tp[e] = acc; acc += (cn[e] + 383) / 384; } tp[64] = acc; of[64] = off[64]; }
    __syncthreads();
    return MoeTiles{tp, of, cn};
}
struct SchedP8 { MoeTiles M; int G, c; const char* A; const char* B; const int* stok;
    __device__ __forceinline__ bool next(int i, pg8::GUnit& u) const { const int uu = i * G + c; int e, ti; if (!M.find(uu >> 2, e, ti)) return false; u.pm = M.off[e] + ti * 256; u.aux = M.off[e] + M.cnt[e]; u.pn = ((uu & 3) << 8) | e; u.nt = 32;
        u.A = A; u.B = B + ((size_t)e * 1024 + (uu & 3) * 256) * 4096; return true; }
    __device__ __forceinline__ unsigned arow(const pg8::GUnit& u, int r) const { const int sl = u.pm + r; const int tk = sl < u.aux ? stok[sl] : 0; return (unsigned)tk * 4096u; } };
struct EpiP8 {
    bf16_t* HDN; const float* srs;
    __device__ __forceinline__ void operator()(const f32x4 (&acc)[2][2][4][2], const pg8::GUnit& u, int wr, int wc, int fr, int fq) const {
        const int pn = u.pn >> 8, j0 = (pn * 256 + wc * 32 + 8 * fq) >> 1;
#pragma unroll
        for (int ai = 0; ai < 2; ++ai)
#pragma unroll
            for (int m = 0; m < 4; ++m) { const int sl = u.pm + ai * 128 + wr * 64 + m * 16 + fr;
                if (sl < u.aux) { const float rs = srs[sl];
#pragma unroll
                    for (int bj = 0; bj < 2; ++bj) { const f32x4 v0 = acc[ai][bj][m][0] * rs, v1 = acc[ai][bj][m][1] * rs;
                        const float h0 = v0[0] * sigmoidf_(v0[0]) * v0[1], h1 = v0[2] * sigmoidf_(v0[2]) * v0[3], h2 = v1[0] * sigmoidf_(v1[0]) * v1[1], h3 = v1[2] * sigmoidf_(v1[2]) * v1[3];
                        u32x2 w; w.x = cvtpk(h0, h1); w.y = cvtpk(h2, h3);
                        *(u32x2*)(HDN + (size_t)sl * 512 + j0 + bj * 64) = w; } } }
    }
};
struct SchedP9 { MoeTiles M; int G, c; const char* A; const char* B;
    __device__ __forceinline__ bool next(int i, pg8::GUnit& u) const { const int uu = i * G + c; int e, ti; if (!M.find(uu >> 3, e, ti)) return false; u.pm = M.off[e] + ti * 256; u.aux = M.off[e] + M.cnt[e]; u.pn = uu & 7; u.nt = 8;
        u.A = A + (size_t)u.pm * 1024; u.B = B + ((size_t)e * 2048 + (uu & 7) * 256) * 1024; return true; } };
struct EpiP9 {
    bf16_t* Y; const float* sw; const int* sdst;
    __device__ __forceinline__ void operator()(const f32x4 (&acc)[2][2][4][2], const pg8::GUnit& u, int wr, int wc, int fr, int fq) const {
        const int col0 = u.pn * 256 + wc * 32 + 8 * fq;
#pragma unroll
        for (int ai = 0; ai < 2; ++ai)
#pragma unroll
            for (int m = 0; m < 4; ++m) { const int sl = u.pm + ai * 128 + wr * 64 + m * 16 + fr;
                if (sl < u.aux) { const float w_ = sw[sl]; bf16_t* yp = Y + (size_t)sdst[sl] * 2048 + col0;
#pragma unroll
                    for (int bj = 0; bj < 2; ++bj) { const f32x4 v0 = acc[ai][bj][m][0] * w_, v1 = acc[ai][bj][m][1] * w_;
                        u32x4 w; w.x = cvtpk(v0[0], v0[1]); w.y = cvtpk(v0[2], v0[3]); w.z = cvtpk(v1[0], v1[1]); w.w = cvtpk(v1[2], v1[3]);
                        *(u32x4*)(yp + bj * 128) = w; } } }
    }
};

struct SchedM4Up { MoeTiles M; int G, c; const char* A; const float* Wg; const float* Wu; const int* stok;
    __device__ __forceinline__ bool next(int i, m4::MUnit& u) const { int tl, ns; if ((G & 63) == 0) { const int x = c & 7, j = c >> 3, tpx = G >> 6; tl = (i * 8 + x) * tpx + (j >> 3); ns = j & 7; } else { const int uu = i * G + c; tl = uu >> 3; ns = uu & 7; }
        int e, ti; if (!M.find(tl, e, ti)) return false; u.pm = M.off[e] + ti * 384; u.aux = M.off[e] + M.cnt[e]; u.ns = ns; u.nK = 64; u.koff = (e * 8 + ns) * 13;
        u.A = A; u.B0 = Wg + (size_t)e * 2048 * 512 + 64 * ns; u.B1 = Wu + (size_t)e * 2048 * 512 + 64 * ns; return true; }
    __device__ __forceinline__ unsigned arow(const m4::MUnit& u, int r) const { const int sl = u.pm + r; const int tk = sl < u.aux ? stok[sl] : 0; return (unsigned)tk * 4096u; } };
struct EpiM4Up {
    bf16_t* HDN; const float* srs;
    __device__ __forceinline__ void operator()(const f32x4 (&acc)[3][8], const m4::MUnit& u, int wid, int fr, int fq) const {
        float rsv[3];
#pragma unroll
        for (int m = 0; m < 3; ++m) { const int sl = u.pm + 48 * wid + 16 * m + fr; rsv[m] = srs[min(sl, u.aux - 1)]; }
        asm volatile("" : "+v"(rsv[0]), "+v"(rsv[1]), "+v"(rsv[2]));
#pragma unroll
        for (int m = 0; m < 3; ++m) { const int sl = u.pm + 48 * wid + 16 * m + fr;
            if (sl < u.aux && 48 * wid + 16 * m + fr < m4::ROWS) { const float rs = rsv[m];
#pragma unroll
                for (int g = 0; g < 4; ++g) { const f32x4 v0 = acc[m][2 * g] * rs, v1 = acc[m][2 * g + 1] * rs;
                    const float h0 = v0[0] * sigmoidf_(v0[0]) * v0[1], h1 = v0[2] * sigmoidf_(v0[2]) * v0[3], h2 = v1[0] * sigmoidf_(v1[0]) * v1[1], h3 = v1[2] * sigmoidf_(v1[2]) * v1[3];
                    u32x2 w; w.x = cvtpk(h0, h1); w.y = cvtpk(h2, h3);
                    *(u32x2*)(HDN + (size_t)sl * 512 + 64 * u.ns + 16 * g + 4 * fq) = w; } } }
    }
};
struct SchedM4Down { MoeTiles M; int G, c; const char* A; const float* Wd;
    __device__ __forceinline__ bool next(int i, m4::MUnit& u) const { int tl, ns; if ((G & 127) == 0) { const int x = c & 7, j = c >> 3, tpx = G >> 7; tl = (i * 8 + x) * tpx + (j >> 4); ns = j & 15; } else { const int uu = i * G + c; tl = uu >> 4; ns = uu & 15; }
        int e, ti; if (!M.find(tl, e, ti)) return false; u.pm = M.off[e] + ti * 384; u.aux = M.off[e] + M.cnt[e]; u.ns = ns; u.nK = 16; u.koff = (e * 16 + ns) * 5;
        u.A = A + (size_t)u.pm * 1024; u.B0 = Wd + (size_t)e * 512 * 2048 + 128 * ns; u.B1 = nullptr; return true; }
    __device__ __forceinline__ unsigned arow(const m4::MUnit&, int) const { return 0u; } };
struct EpiM4Down {
    bf16_t* Y; const float* sw; const int* sdst;
    __device__ __forceinline__ void operator()(const f32x4 (&acc)[3][8], const m4::MUnit& u, int wid, int fr, int fq) const {
        float swv[3]; int sdv[3];
#pragma unroll
        for (int m = 0; m < 3; ++m) { const int slc = min(u.pm + 48 * wid + 16 * m + fr, u.aux - 1); swv[m] = sw[slc]; sdv[m] = sdst[slc]; }
        asm volatile("" : "+v"(swv[0]), "+v"(swv[1]), "+v"(swv[2]), "+v"(sdv[0]), "+v"(sdv[1]), "+v"(sdv[2]));
#pragma unroll
        for (int m = 0; m < 3; ++m) { const int sl = u.pm + 48 * wid + 16 * m + fr;
            if (sl < u.aux) { const float w_ = swv[m]; bf16_t* yp = Y + (size_t)sdv[m] * 2048 + 128 * u.ns + 8 * fq;
#pragma unroll
                for (int g = 0; g < 4; ++g) { const f32x4 v0 = acc[m][2 * g] * w_, v1 = acc[m][2 * g + 1] * w_;
                    u32x4 w; w.x = cvtpk(v0[0], v0[1]); w.y = cvtpk(v0[2], v0[3]); w.z = cvtpk(v1[0], v1[1]); w.w = cvtpk(v1[2], v1[3]);
                    *(u32x4*)(yp + 32 * g) = w; } } }
    }
};
__device__ __forceinline__ void final_phase(Frame& F, const Args& a) {
    const Ids I = phase_ids(F.wave);
    unsigned char* ws = F.ws; const int gw = F.vcu * NWAVES + I.wave, NGW = F.G * NWAVES, lane = I.lane;
    const f32x4* fwp = (const f32x4*)a.in[21] + lane;
    f32x4 fw[8];
#pragma unroll
    for (int j = 0; j < 8; ++j) fw[j] = fwp[64 * j];
    u32x2 h0[8], h1[8], p0[8], p1[8], q0[8], q1[8];
#define FIN_LOAD(t0_, t1c_) do { const u32x2* hp0 = (const u32x2*)((const bf16_t*)(ws + WS_H1B) + (size_t)(t0_) * D) + lane; const u32x2* hp1 = (const u32x2*)((const bf16_t*)(ws + WS_H1B) + (size_t)(t1c_) * D) + lane; \
        const u32x2* ya0 = (const u32x2*)((const bf16_t*)(ws + WS_Y) + (size_t)(2 * (t0_)) * D) + lane; const u32x2* ya1 = (const u32x2*)((const bf16_t*)(ws + WS_Y) + (size_t)(2 * (t1c_)) * D) + lane; \
        _Pragma("unroll") for (int j = 0; j < 8; ++j) { h0[j] = hp0[64 * j]; p0[j] = ya0[64 * j]; q0[j] = ya0[D / 4 + 64 * j]; h1[j] = hp1[64 * j]; p1[j] = ya1[64 * j]; q1[j] = ya1[D / 4 + 64 * j]; } } while (0)
    int t0 = gw;
    if (t0 < SEQ) { const int t1 = t0 + NGW; FIN_LOAD(t0, t1 < SEQ ? t1 : t0); }
    for (; t0 < SEQ; t0 += 2 * NGW) {
        const int t1 = t0 + NGW; const bool has1 = t1 < SEQ; const int t1c = has1 ? t1 : t0;
        f32x4 v0[8], v1[8]; float s0 = 0.f, s1 = 0.f;
#pragma unroll
        for (int j = 0; j < 8; ++j) {
            v0[j] = (f32x4){bflo(h0[j].x) + bflo(p0[j].x) + bflo(q0[j].x), bfhi(h0[j].x) + bfhi(p0[j].x) + bfhi(q0[j].x), bflo(h0[j].y) + bflo(p0[j].y) + bflo(q0[j].y), bfhi(h0[j].y) + bfhi(p0[j].y) + bfhi(q0[j].y)};
            v1[j] = (f32x4){bflo(h1[j].x) + bflo(p1[j].x) + bflo(q1[j].x), bfhi(h1[j].x) + bfhi(p1[j].x) + bfhi(q1[j].x), bflo(h1[j].y) + bflo(p1[j].y) + bflo(q1[j].y), bfhi(h1[j].y) + bfhi(p1[j].y) + bfhi(q1[j].y)};
            s0 += (v0[j][0] * v0[j][0] + v0[j][1] * v0[j][1]) + (v0[j][2] * v0[j][2] + v0[j][3] * v0[j][3]);
            s1 += (v1[j][0] * v1[j][0] + v1[j][1] * v1[j][1]) + (v1[j][2] * v1[j][2] + v1[j][3] * v1[j][3]); }
        const int n0 = t0 + 2 * NGW;
        if (n0 < SEQ) { const int n1 = n0 + NGW; FIN_LOAD(n0, n1 < SEQ ? n1 : n0); }
        const float r0 = rsqrtf(wave_sum(s0) * (1.f / D) + EPS), r1 = rsqrtf(wave_sum(s1) * (1.f / D) + EPS);
        f32x4* o0 = (f32x4*)(a.out + (size_t)t0 * D) + lane; f32x4* o1 = (f32x4*)(a.out + (size_t)t1c * D) + lane;
#pragma unroll
        for (int j = 0; j < 8; ++j) { o0[64 * j] = v0[j] * r0 * fw[j]; if (has1) o1[64 * j] = v1[j] * r1 * fw[j]; }
    }
#undef FIN_LOAD
}
template <int DEPTH> __device__ __forceinline__ void stream_probe(Frame& F, const char* base, size_t bytes) {
    const Ids I = phase_ids(F.wave); const int gw = F.vcu * NWAVES + I.wave, NGW = F.G * NWAVES;
    const size_t per = (bytes / NGW) & ~(size_t)1023; const char* p0 = base + (size_t)gw * per; const int np = (int)(per >> 10);
    const unsigned ldsb = (unsigned)(size_t)F.lds + (unsigned)I.wave * 16384u; const unsigned voff = (unsigned)I.lane * 16u;
    for (int i = 0; i < np; ++i) { const char* b_ = p0 + (size_t)i * 1024; unsigned keep_; const unsigned d_ = (unsigned)__builtin_amdgcn_readfirstlane((int)(ldsb + (i & 15) * 1024));
        asm volatile("s_mov_b32 %0, m0\n\ts_mov_b32 m0, %2\n\ts_nop 0\n\tglobal_load_lds_dwordx4 %1, %3 nt\n\ts_mov_b32 m0, %0" : "=&s"(keep_) : "v"(voff), "s"(d_), "s"(b_) : "memory");
        if (DEPTH == 8) asm volatile("s_waitcnt vmcnt(7)" ::: "memory"); else asm volatile("s_waitcnt vmcnt(15)" ::: "memory"); }
    asm volatile("s_waitcnt vmcnt(0)" ::: "memory");
    __syncthreads();
}


template <int DEPTH> __device__ __forceinline__ void stream_probe_sliced(Frame& F, const char* base, size_t bytes) {
    const Ids I = phase_ids(F.wave); const int gw = F.vcu * NWAVES + I.wave, NGW = F.G * NWAVES;
#ifdef MK_PROBE3
    const int bx = blockIdx.x, slice = (bx >> 3) & 7, grpw = ((bx & 7) + 8 * (bx >> 6)) * NWAVES + I.wave, ngrp = NGW >> 3;
#else
    const int grpw = gw >> 3, slice = gw & 7, ngrp = NGW >> 3;
#endif
    const size_t rows_total = bytes >> 11; const size_t rows_per = (rows_total / ngrp) & ~(size_t)3; const char* p0 = base + (size_t)grpw * rows_per * 2048 + slice * 256;
    const int np = (int)(rows_per >> 2);
    const unsigned ldsb = (unsigned)(size_t)F.lds + (unsigned)I.wave * 16384u; const unsigned voff = (unsigned)((I.lane >> 4) * 2048 + (I.lane & 15) * 16);
    for (int i = 0; i < np; ++i) { const char* b_ = p0 + (size_t)i * 8192; unsigned keep_; const unsigned d_ = (unsigned)__builtin_amdgcn_readfirstlane((int)(ldsb + (i & 15) * 1024));
        asm volatile("s_mov_b32 %0, m0\n\ts_mov_b32 m0, %2\n\ts_nop 0\n\tglobal_load_lds_dwordx4 %1, %3 nt\n\ts_mov_b32 m0, %0" : "=&s"(keep_) : "v"(voff), "s"(d_), "s"(b_) : "memory");
        if (DEPTH == 8) asm volatile("s_waitcnt vmcnt(7)" ::: "memory"); else asm volatile("s_waitcnt vmcnt(15)" ::: "memory"); }
    asm volatile("s_waitcnt vmcnt(0)" ::: "memory");
    __syncthreads();
}

__global__ void __launch_bounds__(NTHR, 2) mega_fwd(Args args) {
    extern __shared__ __attribute__((aligned(16))) unsigned char lds_raw[];
    Frame F;
    F.lds = (LAS unsigned char*)lds_raw; F.MISC = (volatile LAS unsigned*)(F.lds + MISC_OFF);
    F.G = gridDim.x; { const int bx = blockIdx.x; F.vcu = (F.G % 8 == 0) ? (bx % 8) * (F.G / 8) + bx / 8 : bx; }
    F.ws = args.ws;
    unsigned char* ws = args.ws;
    F.wave = __builtin_amdgcn_readfirstlane((int)(threadIdx.x >> 6));
    for (int u = opaque_tid(F.wave); u < (LDS_BYTES - MISC_OFF) / 4; u += NTHR) ((LAS unsigned*)(F.lds + MISC_OFF))[u] = 0u;
    __syncthreads();
    XcdBarrier bar = xcd_barrier_post((unsigned*)(ws + WS_CTL) + CW_BAR, F.MISC + 8);
    if (args.never) cg::this_grid().sync();
    const int lo = args.ph_lo, hi = args.ph_hi;
#define IN(k) (lo <= (k) && (k) < hi)
#define SEAM(k) do { if (IN(k) && IN((k) + 1)) xcd_barrier(bar); } while (0)
#ifndef MK_EARLY
#define MK_EARLY true
#endif
#ifndef MK_EARLY1
#define MK_EARLY1 false
#endif
#ifndef MK_REPEAT
#define MK_REPEAT -1
#endif
#define REPS(k) for (int rep_ = 0; rep_ < ((k) == MK_REPEAT ? 2 : 1); ++rep_, ((k) == MK_REPEAT && rep_ == 1) ? xcd_barrier(bar) : (void)0)
    if (IN(0)) REPS(0) { p0_prologue(F, args); }
    SEAM(0);
    if (IN(1)) REPS(1) {
        meta_stage1(F);
        weff_stage(F);
        SchedP1 S; S.T.init(32, 24, F.G, (int)blockIdx.x); S.A = (const char*)(ws + WS_XN); S.B = (const char*)(ws + WS_WIN);
        EpiP1 E{(bf16_t*)(ws + WS_CQKV2), (float*)(ws + WS_SSQ), (bf16_t*)(ws + WS_U), (bf16_t*)(ws + WS_G), (bf16_t*)(ws + WS_K), (const f32x2*)(ws + WS_ROPE)};
        pg8::gemm_phase<EpiP1, SchedP1, false, false, false, MK_EARLY1>(F.wave, F.lds, 4096, 4096, S, E);
    }
    SEAM(1);
    if (IN(2)) REPS(2) {
        pool_phase(F);
#ifdef MK_POOLREP
        for (int pr_ = 0; pr_ < MK_POOLREP; ++pr_) { __syncthreads(); pool_phase(F); }
#endif
        meta_stage2(F);
        SchedP2 S; S.init(F.G, (int)blockIdx.x, (const char*)(ws + WS_CQKV2), (const char*)(ws + WS_WQKV2), (const char*)(ws + WS_XN), (const char*)(ws + WS_WIN) + (size_t)6144 * 4096);
        LAS float* rtab = (LAS float*)(F.lds + MISC_OFF + 1024);
        { const float* SSQ = (const float*)(ws + WS_SSQ); pg8::GUnit u; const int tid_ = opaque_tid(F.wave);
          for (int i = 0; i < 5; ++i) if (S.next(i, u) && u.pn != 28 && tid_ < 256) { const f32x4* sp = (const f32x4*)(SSQ + ((size_t)(u.pn >= 12 ? 1 : 0) * SEQ + u.pm * 256 + tid_) * 16);
              const f32x4 a0 = sp[0], a1 = sp[1], a2 = sp[2], a3 = sp[3]; const float ssum = ((a0[0] + a0[1]) + (a0[2] + a0[3])) + ((a1[0] + a1[1]) + (a1[2] + a1[3])) + ((a2[0] + a2[1]) + (a2[2] + a2[3])) + ((a3[0] + a3[1]) + (a3[2] + a3[3]));
              rtab[u.aux * 256 + tid_] = rsqrtf(ssum * (1.f / 512.f) + EPS); } }
        __syncthreads();
        EpiP2 E{(bf16_t*)(ws + WS_Q), (bf16_t*)(ws + WS_K), (bf16_t*)(ws + WS_V), (const f32x2*)(ws + WS_ROPE), rtab};
#ifdef MK_P2ABL
        E.abl = (rep_ == 1) ? MK_P2ABL : 0;
#endif
        pg8::gemm_phase<EpiP2, SchedP2, false, false, false, MK_EARLY>(F.wave, F.lds, 4096, 4096, S, E);
    }
    SEAM(2);
    if (IN(3)) {
        for (int pu_ = F.vcu; pu_ < (MK_REPEAT == 3 ? 512 : 256); pu_ += F.G) { const int pu = pu_ & 255, h = pu >> 4, sq = pu & 15;
            at::attn_unit(F.wave, h, 31 - sq, ws, (unsigned)WS_Q, (unsigned)WS_K, (unsigned)WS_V, (unsigned)WS_O, F.lds);
            at::attn_unit(F.wave, h, sq, ws, (unsigned)WS_Q, (unsigned)WS_K, (unsigned)WS_V, (unsigned)WS_O, F.lds); }
    }
    SEAM(3);
    if (IN(4)) REPS(4) {
        SchedP4 S; S.T.init(32, 8, F.G, (int)blockIdx.x); S.A0 = (const char*)(ws + WS_O); S.B0 = (const char*)(ws + WS_WO); S.A1 = (const char*)(ws + WS_PL); S.B1 = (const char*)(ws + WS_WPE);
        EpiP4 E{(const bf16_t*)(ws + WS_G), (bf16_t*)(ws + WS_MG)};
        pg8::gemm_phase<EpiP4, SchedP4, false, false, true>(F.wave, F.lds, 4096, 4096, S, E);
    }
    SEAM(4);
    if (IN(5)) REPS(5) {
        SchedP5 S; S.T.init(32, 8, F.G, (int)blockIdx.x); S.A = (const char*)(ws + WS_MG); S.B = (const char*)(ws + WS_WOUT);
        EpiP5 E{args.in[0], (float*)(ws + WS_H1), (bf16_t*)(ws + WS_H1B), (float*)(ws + WS_SS2), (bf16_t*)(ws + WS_H1S), args.in[13]};
        pg8::gemm_phase<EpiP5, SchedP5, false, true>(F.wave, F.lds, 4096, 4096, S, E);
    }
    SEAM(5);
#ifdef MK_BARPROBE
    if (IN(6)) { for (int i_ = 0; i_ < MK_BARPROBE; ++i_) xcd_barrier(bar); }
#endif
#ifdef MK_P6ABL
    if (IN(6)) REPS(6) router_phase(F, args, rep_ == 1 ? MK_P6ABL : 0);
#else
    if (IN(6)) REPS(6) router_phase(F, args);
#endif
    SEAM(6);
    if (IN(7)) REPS(7) slots_phase(F);
    SEAM(7);
#ifdef MK_STREAMPROBE2
    if (IN(8)) { stream_probe_sliced<MK_STREAMPROBE2>(F, (const char*)args.in[18], (size_t)64 * 2048 * 512 * 4); stream_probe_sliced<MK_STREAMPROBE2>(F, (const char*)args.in[19], (size_t)64 * 2048 * 512 * 4); stream_probe_sliced<MK_STREAMPROBE2>(F, (const char*)args.in[20], (size_t)64 * 2048 * 512 * 4); xcd_barrier(bar); }
#endif
#ifdef MK_STREAMPROBE
    if (IN(8)) { stream_probe<MK_STREAMPROBE>(F, (const char*)args.in[18], (size_t)64 * 2048 * 512 * 4); stream_probe<MK_STREAMPROBE>(F, (const char*)args.in[19], (size_t)64 * 2048 * 512 * 4); stream_probe<MK_STREAMPROBE>(F, (const char*)args.in[20], (size_t)64 * 2048 * 512 * 4); xcd_barrier(bar); }
#endif
    if (IN(8)) REPS(8) {
        const MoeTiles M = moe_tiles_build(F);
        SchedM4Up S{M, F.G, (int)blockIdx.x, (const char*)(ws + WS_H1S), args.in[18], args.in[19], (const int*)(ws + RT_STOK)};
        EpiM4Up E{(bf16_t*)(ws + WS_HDN), (const float*)(ws + RT_SRS)};
        m4::moe_phase<0, SchedM4Up, EpiM4Up>(F.wave, F.lds, S, E, args.in[13]);
#ifdef MK_ABL8
        xcd_barrier(bar);
        m4::moe_phase<0, SchedM4Up, EpiM4Up, MK_ABL8>(F.wave, F.lds, S, E, args.in[13]);
#endif
    }
    SEAM(8);
    if (IN(9)) REPS(9) {
        const MoeTiles M = moe_tiles_build(F);
        SchedM4Down S{M, F.G, (int)blockIdx.x, (const char*)(ws + WS_HDN), args.in[20]};
        EpiM4Down E{(bf16_t*)(ws + WS_Y), (const float*)(ws + RT_SW), (const int*)(ws + RT_SDST)};
        m4::moe_phase<1, SchedM4Down, EpiM4Down>(F.wave, F.lds, S, E, nullptr);
#ifdef MK_ABL9
        xcd_barrier(bar);
        m4::moe_phase<1, SchedM4Down, EpiM4Down, MK_ABL9>(F.wave, F.lds, S, E, nullptr);
#endif
    }
    SEAM(9);
    if (IN(10)) REPS(10) final_phase(F, args);
#undef IN
#undef SEAM
}

constexpr int N_PHASES = 11;
static int g_grid = 0;
inline bool mk_setup() {
    if (g_grid != 0) return g_grid > 0;
    int dev = 0, cus = 0, per_cu = 0;
    if (hipGetDevice(&dev) != hipSuccess || hipDeviceGetAttribute(&cus, hipDeviceAttributeMultiprocessorCount, dev) != hipSuccess) { g_grid = -1; return false; }
    if (hipFuncSetAttribute((const void*)mega_fwd, hipFuncAttributeMaxDynamicSharedMemorySize, LDS_BYTES) != hipSuccess) { fprintf(stderr, "mk: hipFuncSetAttribute failed\n"); g_grid = -1; return false; }
    if (hipOccupancyMaxActiveBlocksPerMultiprocessor(&per_cu, (const void*)mega_fwd, NTHR, LDS_BYTES) != hipSuccess || per_cu < 1) { fprintf(stderr, "mk: occupancy query says %d\n", per_cu); (void)hipGetLastError(); g_grid = -1; return false; }
    g_grid = cus;
    return true;
}
inline void mk_launch(void* const* d_in, float* d_out, unsigned char* ws, int ph_lo, int ph_hi, hipStream_t stream) {
    if (!mk_setup()) return;
    Args a{};
    for (int i = 0; i < 22; ++i) a.in[i] = (const float*)d_in[i];
    a.out = d_out; a.ws = ws; a.ph_lo = ph_lo; a.ph_hi = ph_hi; a.never = 0; a.pad = 0;
    void* kargs[] = {&a};
    hipError_t e = hipLaunchCooperativeKernel((const void*)mega_fwd, dim3(g_grid), dim3(NTHR), kargs, LDS_BYTES, stream);
    if (e != hipSuccess) fprintf(stderr, "mk: cooperative launch failed: %s (grid %d)\n", hipGetErrorString(e), g_grid);
}
}
extern "C" void kernel_launch(void* const* d_in, const int* in_sizes, int n_in, void* d_out, int out_size, void* d_ws, size_t ws_size, hipStream_t stream) {
    (void)in_sizes; (void)n_in; (void)ws_size; (void)out_size;
    unsigned char* ws = (unsigned char*)d_ws;
    (void)hipMemsetAsync(ws + mk::WS_CTL, 0, mk::CTL_ZERO_BYTES, stream);
#ifdef MK_SPLIT
    for (int p = 0; p < mk::N_PHASES; ++p) mk::mk_launch(d_in, (float*)d_out, ws, p, p + 1, stream);
#else
    mk::mk_launch(d_in, (float*)d_out, ws, 0, mk::N_PHASES, stream);
#endif
}
```

```cpp
#define MK_KOFF 1
#include <hip/hip_runtime.h>
#include <hip/hip_cooperative_groups.h>
#include <cstdint>
#include <cstddef>
#include <cstdio>
namespace mk {
namespace cg = cooperative_groups;
#define LAS __attribute__((address_space(3)))
#define GAS __attribute__((address_space(1)))
typedef unsigned short bf16_t;
typedef short bf16x8 __attribute__((ext_vector_type(8)));
typedef short s16x4 __attribute__((ext_vector_type(4)));
typedef float f32x4 __attribute__((ext_vector_type(4)));
typedef float f32x2 __attribute__((ext_vector_type(2)));
typedef float f32x16 __attribute__((ext_vector_type(16)));
typedef unsigned u32x4 __attribute__((ext_vector_type(4)));
typedef unsigned u32x2 __attribute__((ext_vector_type(2)));
typedef __bf16 bf16x2_t __attribute__((ext_vector_type(2)));

constexpr int D = 2048, SEQ = 8192, NMETA = 16, LTOT = SEQ + NMETA;
constexpr int NH = 16, QKD = 192, VD = 128;
constexpr int KROWS = SEQ + 64;
constexpr int NE = 64, FF = 512;
constexpr float EPS = 1e-6f;
constexpr int NWAVES = 8, NTHR = 512;

__device__ __forceinline__ unsigned cvtpk(float lo, float hi) { f32x2 v = {lo, hi}; bf16x2_t b = __builtin_convertvector(v, bf16x2_t); return __builtin_bit_cast(unsigned, b); }
__device__ __forceinline__ float bf2f(unsigned short b) { return __uint_as_float((unsigned)b << 16); }
__device__ __forceinline__ float bflo(unsigned w) { return __uint_as_float(w << 16); }
__device__ __forceinline__ float bfhi(unsigned w) { return __uint_as_float(w & 0xffff0000u); }
__device__ __forceinline__ unsigned short f2bf(float f) { return (unsigned short)(cvtpk(f, 0.f) & 0xffffu); }
__device__ __forceinline__ float wave_sum(float v) {
#pragma unroll
    for (int o = 1; o < 64; o <<= 1) v += __shfl_xor(v, o);
    return v;
}
__device__ __forceinline__ int lane_id() { unsigned m = ~0u; asm volatile("" : "+s"(m)); return (int)__builtin_amdgcn_mbcnt_hi(m, __builtin_amdgcn_mbcnt_lo(m, 0u)); }
__device__ __forceinline__ int opaque_tid(int wave) { return wave * 64 + lane_id(); }
__device__ __forceinline__ float sigmoidf_(float x) { return __builtin_amdgcn_rcpf(1.f + __builtin_amdgcn_exp2f(-1.4426950408889634f * x)); }

#define XB_TMO      128
#define XB_XCNT(j)  (256  + 64 * (j))
#define XB_XSUB(j)  (1280 + 64 * (j))
#define XB_XGEN(j)  (2304 + 64 * (j))
#define XB_TOP      3328
#define XB_TOPGEN   3392
#define XCD_BAR_WORDS 3456
#define XB_SPIN_CAP (1u << 20)
__device__ __forceinline__ unsigned xb_ld(unsigned* p)              { return __hip_atomic_load(p, __ATOMIC_RELAXED, __HIP_MEMORY_SCOPE_AGENT); }
__device__ __forceinline__ unsigned xb_add(unsigned* p, unsigned v) { return __hip_atomic_fetch_add(p, v, __ATOMIC_RELAXED, __HIP_MEMORY_SCOPE_AGENT); }
__device__ __forceinline__ unsigned xb_xcc_id() { return (unsigned)__builtin_amdgcn_s_getreg((3 << 11) | 20) & 0xFu; }
#define XB_SPIN(cond, bar) do { unsigned _sp = 0; while (cond) { __builtin_amdgcn_s_sleep(1); \
    if ((++_sp & 255u) == 0u) { if (xb_ld(&(bar)[XB_TMO])) break; if (_sp > XB_SPIN_CAP) { atomicAdd(&(bar)[XB_TMO], 1u); break; } } } } while (0)
struct XcdBarrier { unsigned* bar; unsigned x; volatile LAS unsigned* st; };
__device__ __forceinline__ XcdBarrier xcd_barrier_post(unsigned* bar, volatile LAS unsigned* st) {
    XcdBarrier b; b.bar = bar; b.x = xb_xcc_id(); b.st = st;
    if (threadIdx.x == 0) (void)xb_add(&bar[XB_XCNT(b.x)], 1u);
    return b;
}
__device__ __forceinline__ void xcd_barrier_complete(unsigned* bar, unsigned x, unsigned& nloc, unsigned& nx) {
    const unsigned G = gridDim.x * gridDim.y * gridDim.z;
    unsigned sum, cnt, mine, sp = 0u;
    for (;;) {
        sum = 0u; cnt = 0u; mine = 0u;
#pragma unroll
        for (unsigned j = 0; j < 16; ++j) { const unsigned c = xb_ld(&bar[XB_XCNT(j)]); sum += c; cnt += (c > 0u) ? 1u : 0u; mine = (j == x) ? c : mine; }
        if (sum == G) break;
        __builtin_amdgcn_s_sleep(1);
        if ((++sp & 255u) == 0u) { if (xb_ld(&bar[XB_TMO])) break; if (sp > XB_SPIN_CAP) { atomicAdd(&bar[XB_TMO], 1u); break; } }
    }
    nloc = mine > 0u ? mine : 1u; nx = cnt > 0u ? cnt : 1u;
}
__device__ __forceinline__ void xcd_barrier(const XcdBarrier& b) {
    asm volatile("s_waitcnt vmcnt(0)" ::: "memory");
    __syncthreads();
    if (threadIdx.x == 0) {
        unsigned* bar = b.bar;
        __builtin_amdgcn_s_waitcnt(0);
        unsigned nloc = b.st[0], nx = b.st[1];
        if (nloc == 0u) { xcd_barrier_complete(bar, b.x, nloc, nx); b.st[0] = nloc; b.st[1] = nx; }
        const unsigned old = xb_add(&bar[XB_XSUB(b.x)], 1u);
        const unsigned gen = old / nloc;
        if (old + 1u == (gen + 1u) * nloc) {
            __builtin_amdgcn_fence(__ATOMIC_RELEASE, "agent");
            asm volatile("s_waitcnt vmcnt(0)" ::: "memory");
            const unsigned og = xb_add(&bar[XB_TOP], 1u);
            const unsigned tg = og / nx;
            if (og + 1u == (tg + 1u) * nx) xb_add(&bar[XB_TOPGEN], 1u);
            else XB_SPIN(xb_ld(&bar[XB_TOPGEN]) == tg, bar);
            __builtin_amdgcn_fence(__ATOMIC_ACQUIRE, "agent");
            xb_add(&bar[XB_XGEN(b.x)], 1u);
            asm volatile("s_waitcnt vmcnt(0)" ::: "memory");
        } else {
            XB_SPIN(xb_ld(&bar[XB_XGEN(b.x)]) == gen, bar);
            __builtin_amdgcn_fence(__ATOMIC_ACQUIRE, "agent");
            asm volatile("s_waitcnt vmcnt(0)" ::: "memory");
        }
    }
    __syncthreads();
}

namespace pg8 {
constexpr int BM = 256, BK = 64, HALF = 128, HTB = HALF * BK * 2, STAGE_BYTES = 8 * HTB;
__host__ __device__ __forceinline__ int lds_byte(int r, int c) { const int st = (r >> 4) * 2 + (c >> 5), rr = r & 15, cc = c & 31, ob = rr * 64 + cc * 2; return st * 1024 + (ob ^ (((ob >> 9) & 1) << 5)); }
__host__ __device__ __forceinline__ void stage_rc(int b, int& R, int& C) { const int st = b / 1024, sb = b % 1024, swz = sb ^ (((sb >> 9) & 1) << 5); R = (st >> 1) * 16 + swz / 64; C = (st & 1) * 32 + (swz % 64) / 2; }
__host__ __device__ __forceinline__ int perm32(int rho) { const int n = rho >> 4, i = rho & 15; return 8 * (i >> 2) + 4 * n + (i & 3); }

struct GUnit { const char* A; const char* B; int nt; int pm, pn, aux; };

template <bool GATH, class Sched> __device__ __forceinline__ unsigned arow_off(const Sched& S, const GUnit& u, int r, int lda_b) {
    if constexpr (GATH) return (unsigned)S.arow(u, r); else return (unsigned)(r * lda_b);
}
template <class Epi, class Sched, bool GATH = false, bool ACCINIT = false, bool CARRY = false, bool EARLY = false>
__device__ __forceinline__ void gemm_phase(const int wave_, LAS unsigned char* lds, const int lda_b, const int ldb_b, const Sched& S, const Epi& E) {
    const int wid = wave_, lane = lane_id(), tid = wid * 64 + lane, wr = wid >> 2, wc = wid & 3, fr = lane & 15, fq = lane >> 4;
    int sR[2], sC[2];
    unsigned voffA[2][2], voffB[2];
#pragma unroll
    for (int i = 0; i < 2; ++i) { int R, C; stage_rc(tid * 16 + i * 8192, R, C); sR[i] = R; sC[i] = C; const int Rb = (R & ~31) + perm32(R & 31);
        voffB[i] = (unsigned)(Rb * ldb_b + C * 2); }
    const size_t kstep = (size_t)(BK * 2);
    const size_t hstepB = (size_t)HALF * ldb_b;
    const unsigned ldsw = (unsigned)wid * 1024u;
    const int aoff = lds_byte(wr * 64 + fr, fq * 8), boff = lds_byte(wc * 32 + fr, fq * 8);
#define PG8_SA(b, h) (((b) * 2 + (h)) * HTB)
#define PG8_SB(b, h) ((4 + (b) * 2 + (h)) * HTB)
#define PG8_STAGE(bufoff, gbase, voff) do { _Pragma("unroll") for (int _i = 0; _i < 2; ++_i) \
        __builtin_amdgcn_global_load_lds((const unsigned*)((const char*)(gbase) + (voff)[_i]), (LAS unsigned*)(lds + (bufoff) + ldsw + _i * 8192), 16, 0, 0); } while (0)
#define PG8_LDA(dst, b, h) do { _Pragma("unroll") for (int m = 0; m < 4; ++m) _Pragma("unroll") for (int k = 0; k < 2; ++k) dst[m][k] = *(const LAS bf16x8*)(lds + PG8_SA(b, h) + aoff + m * 2048 + k * 1024); } while (0)
#define PG8_LDB(dst, b, h) do { _Pragma("unroll") for (int n = 0; n < 2; ++n) _Pragma("unroll") for (int k = 0; k < 2; ++k) dst[n][k] = *(const LAS bf16x8*)(lds + PG8_SB(b, h) + boff + n * 2048 + k * 1024); } while (0)
#define PG8_MMA(ai, bj, At, Bt) do { __builtin_amdgcn_s_setprio(1); _Pragma("unroll") for (int m = 0; m < 4; ++m) _Pragma("unroll") for (int n = 0; n < 2; ++n) _Pragma("unroll") for (int k = 0; k < 2; ++k) \
        acc[ai][bj][m][n] = __builtin_amdgcn_mfma_f32_16x16x32_bf16(Bt[n][k], At[m][k], acc[ai][bj][m][n], 0, 0, 0); __builtin_amdgcn_s_setprio(0); } while (0)
#define PG8_WAIT_V(n) asm volatile("s_waitcnt vmcnt(" #n ")" ::: "memory")
#define PG8_WAIT_L(n) asm volatile("s_waitcnt lgkmcnt(" #n ")" ::: "memory")
#define PG8_BAR __builtin_amdgcn_s_barrier()
#define PG8_SCHED __builtin_amdgcn_sched_barrier(0)
#define PG8_VOFFA(dst, u) do { _Pragma("unroll") for (int _h = 0; _h < 2; ++_h) _Pragma("unroll") for (int _i = 0; _i < 2; ++_i) \
        dst[_h][_i] = arow_off<GATH>(S, u, _h * HALF + sR[_i], lda_b) + (unsigned)(sC[_i] * 2); } while (0)
    GUnit cur, nxt; int ui = 0; bool post = false; (void)post;
    if (!S.next(0, cur)) return;
    f32x4 acc[2][2][4][2];
    if constexpr (ACCINIT) E.init(acc, cur, wr, wc, fr, fq);
    else {
#pragma unroll
    for (int a = 0; a < 2; ++a)
#pragma unroll
        for (int b = 0; b < 2; ++b)
#pragma unroll
            for (int m = 0; m < 4; ++m)
#pragma unroll
                for (int n = 0; n < 2; ++n) acc[a][b][m][n] = (f32x4){0.f, 0.f, 0.f, 0.f};
    }
    bf16x8 At[4][2], B0[2][2], B1[2][2];
    const char* cA = cur.A; const char* cB = cur.B;
    PG8_VOFFA(voffA, cur);
    unsigned voffN[2][2];
#pragma unroll
    for (int h = 0; h < 2; ++h)
#pragma unroll
        for (int i = 0; i < 2; ++i) voffN[h][i] = voffA[h][i];
    PG8_STAGE(PG8_SB(0, 0), cB, voffB); PG8_STAGE(PG8_SB(0, 1), cB + hstepB, voffB); PG8_STAGE(PG8_SA(0, 0), cA, voffA[0]); PG8_STAGE(PG8_SA(0, 1), cA, voffA[1]);
    if (wr == 1) PG8_BAR;
    PG8_WAIT_V(2); PG8_BAR;
    PG8_STAGE(PG8_SB(1, 0), cB + kstep, voffB); PG8_STAGE(PG8_SA(1, 0), cA + kstep, voffA[0]); PG8_STAGE(PG8_SB(1, 1), cB + hstepB + kstep, voffB);
    PG8_WAIT_V(6); PG8_BAR;
    for (;;) {
        const bool has_next = S.next(ui + 1, nxt);
        const char* nA = has_next ? nxt.A : cA; const char* nB = has_next ? nxt.B : cB;
        if (GATH) { if (has_next) PG8_VOFFA(voffN, nxt); }
        const int nt = cur.nt;
        for (int t = 0; t < nt; t += 2) {
            const bool last = (t == nt - 2);
            const char* a1 = cA + (size_t)(t + 1) * kstep;
            const char* a2 = last ? nA : cA + (size_t)(t + 2) * kstep; const char* b2 = last ? nB : cB + (size_t)(t + 2) * kstep;
            const char* a3 = a2 + kstep; const char* b3 = b2 + kstep;
            unsigned vA2[2][2];
#pragma unroll
            for (int h = 0; h < 2; ++h)
#pragma unroll
                for (int i = 0; i < 2; ++i) vA2[h][i] = (GATH && last) ? voffN[h][i] : voffA[h][i];
            const bool relaxed = EARLY && post && t == 0;
#define PG8_WAIT_VX(NR) do { if (relaxed) PG8_WAIT_V(NR); else PG8_WAIT_V(8); } while (0)
            PG8_LDB(B0, 0, 0); PG8_LDB(B1, 0, 1); PG8_SCHED; PG8_LDA(At, 0, 0); if (!relaxed) PG8_STAGE(PG8_SA(1, 1), a1, voffA[1]);
            PG8_WAIT_VX(26); PG8_WAIT_L(0); PG8_BAR; PG8_MMA(0, 0, At, B0); PG8_MMA(0, 1, At, B1); PG8_BAR; PG8_SCHED;
            PG8_LDA(At, 0, 1); PG8_STAGE(PG8_SB(0, 0), b2, voffB); PG8_STAGE(PG8_SB(0, 1), b2 + hstepB, voffB); PG8_STAGE(PG8_SA(0, 0), a2, vA2[0]);
            PG8_WAIT_VX(30); PG8_WAIT_L(0); PG8_BAR; PG8_MMA(1, 0, At, B0); PG8_MMA(1, 1, At, B1); PG8_BAR; PG8_SCHED;
            PG8_LDB(B0, 1, 0); PG8_LDB(B1, 1, 1); PG8_SCHED; PG8_LDA(At, 1, 0); PG8_STAGE(PG8_SA(0, 1), a2, vA2[1]);
            PG8_WAIT_VX(26); PG8_WAIT_L(0); PG8_BAR; PG8_MMA(0, 0, At, B0); PG8_MMA(0, 1, At, B1); PG8_BAR; PG8_SCHED;
            PG8_LDA(At, 1, 1); PG8_STAGE(PG8_SB(1, 0), b3, voffB); PG8_STAGE(PG8_SB(1, 1), b3 + hstepB, voffB); PG8_STAGE(PG8_SA(1, 0), a3, vA2[0]);
            PG8_WAIT_VX(30); PG8_WAIT_L(0); PG8_BAR; PG8_MMA(1, 0, At, B0); PG8_MMA(1, 1, At, B1); PG8_BAR; PG8_SCHED;
#undef PG8_WAIT_VX
        }
        if (wr == 0) PG8_BAR;
        if constexpr (EARLY) { post = has_next && E.nstores(cur) >= 16;
            if (post) PG8_STAGE(PG8_SA(1, 1), nA + kstep, (GATH ? voffN[1] : voffA[1])); }
        bool carried = false;
        const int le_ = lane_id(), fre = le_ & 15, fqe = le_ >> 4;
        if constexpr (CARRY) { if (has_next && E.carry(cur)) { E.rescale(acc, cur, wr, wc, fre, fqe); carried = true; } }
        if (!carried) E(acc, cur, wr, wc, fre, fqe);
        if (!has_next) break;
        if constexpr (ACCINIT) E.init(acc, nxt, wr, wc, fre, fqe);
        else if (!carried) {
#pragma unroll
        for (int a = 0; a < 2; ++a)
#pragma unroll
            for (int b = 0; b < 2; ++b)
#pragma unroll
                for (int m = 0; m < 4; ++m)
#pragma unroll
                    for (int n = 0; n < 2; ++n) acc[a][b][m][n] = (f32x4){0.f, 0.f, 0.f, 0.f};
        }
        cur = nxt; cA = nA; cB = nB; ++ui;
        if (GATH) {
#pragma unroll
            for (int h = 0; h < 2; ++h)
#pragma unroll
                for (int i = 0; i < 2; ++i) voffA[h][i] = voffN[h][i];
        }
        if (wr == 1) PG8_BAR;
    }
    PG8_WAIT_V(0);
    PG8_BAR;
#undef PG8_SA
#undef PG8_SB
#undef PG8_STAGE
#undef PG8_LDA
#undef PG8_LDB
#undef PG8_MMA
#undef PG8_WAIT_V
#undef PG8_WAIT_L
#undef PG8_BAR
#undef PG8_SCHED
#undef PG8_VOFFA
}
struct TileOrder {
    int nM, nN, nwg, G, c;
    __device__ __forceinline__ void init(int nM_, int nN_, int G_, int c_) { nM = nM_; nN = nN_; nwg = nM * nN; G = G_; c = c_; }
    __device__ __forceinline__ bool tile(int i, int& pm, int& pn) const {
        const long Lq = (long)i * G + c; if (Lq >= nwg) return false;
        int wgid = (int)Lq; { const int q = nwg / 8, r = nwg % 8, xcd = wgid % 8, off = wgid / 8; wgid = (xcd < r ? xcd * (q + 1) : r * (q + 1) + (xcd - r) * q) + off; }
        const int nig = 8 * nN, gid = wgid / nig, fm = gid * 8, gsz = (nM - fm) < 8 ? (nM - fm) : 8;
        pm = fm + ((wgid % nig) % gsz); pn = (wgid % nig) / gsz; return true;
    }
};
}
}
namespace mk { namespace at {
constexpr int SHM_K = 64 * 192 * 2, SHM_V = 64 * 128 * 2;
constexpr int LDS_V = 0, LDS_K = 2 * SHM_V, LDS_WS = LDS_K + 2 * SHM_K, LDS_QR = LDS_WS + 8 * 256, LDS_TOTAL = LDS_QR + 8 * 4096;
constexpr float THRL = 11.5f;
#define KSWZ(row, colB) ((row) * 256 + ((colB) ^ (((row) & 15) << 4)))
#define SBAR() __builtin_amdgcn_sched_barrier(0)
__device__ __forceinline__ int v_st(int k, int c) { const int kk = (k & ~0xC) | ((k & 4) << 1) | ((k & 8) >> 1); return ((kk >> 3) * 4 + (c >> 5)) * 512 + ((kk & 7) * 32 + (c & 31)) * 2; }
__device__ __forceinline__ int v_rd_base(int lane) { return ((lane & 3) << 3) | (((lane >> 2) & 3) << 6) | (((lane >> 4) & 1) << 5) | (((lane >> 5) & 1) << 8); }
constexpr int v_rd_off(int d0, int ks, int half) { return d0 * 512 + ks * 4096 + half * 2048; }
__device__ __forceinline__ int crow(int r, int hi) { return (r & 3) + 8 * (r >> 2) + 4 * hi; }

__device__ __forceinline__ void mask_causal(f32x16& p0, f32x16& p1, int dq) {
    const float NEG = -__builtin_inff();
#pragma unroll
    for (int r = 0; r < 16; ++r) { const int c = (r & 3) + 8 * (r >> 2); if (dq - c < 0) p0[r] = NEG; if (dq - c - 32 < 0) p1[r] = NEG; }
}
__device__ __forceinline__ void mask_meta(f32x16& p0, f32x16& p1) {
    const float NEG = -__builtin_inff();
#pragma unroll
    for (int r = 0; r < 16; ++r) { if (r >= 8) p0[r] = NEG; p1[r] = NEG; }
}
__device__ __forceinline__ void partialSM(f32x16& p0, f32x16& p1, float& m_reg, float& alpha) {
    float pmax = p0[0];
#pragma unroll
    for (int r = 1; r < 16; ++r) pmax = fmaxf(pmax, p0[r]);
#pragma unroll
    for (int r = 0; r < 16; ++r) pmax = fmaxf(pmax, p1[r]);
    { auto rr = __builtin_amdgcn_permlane32_swap(__float_as_uint(pmax), __float_as_uint(pmax), false, false);
      pmax = fmaxf(__uint_as_float(rr[0]), __uint_as_float(rr[1])); }
    float mn;
    if (__builtin_expect(__all((pmax - m_reg) <= THRL), 1)) { mn = m_reg; alpha = 1.f; }
    else { mn = fmaxf(m_reg, pmax); alpha = __builtin_amdgcn_exp2f(m_reg - mn); m_reg = mn; }
#pragma unroll
    for (int r = 0; r < 16; ++r) p0[r] = __builtin_amdgcn_exp2f(p0[r] - mn);
#pragma unroll
    for (int r = 0; r < 16; ++r) p1[r] = __builtin_amdgcn_exp2f(p1[r] - mn);
}
__device__ __forceinline__ void finishSM(const f32x16& p0, const f32x16& p1, float alpha, float& l_reg, bf16x8& pa0, bf16x8& pa1, bf16x8& pa2, bf16x8& pa3) {
    float ps = 0.f;
#pragma unroll
    for (int r = 0; r < 16; ++r) ps += p0[r];
#pragma unroll
    for (int r = 0; r < 16; ++r) ps += p1[r];
    { auto rr = __builtin_amdgcn_permlane32_swap(__float_as_uint(ps), __float_as_uint(ps), false, false);
      ps = __uint_as_float(rr[0]) + __uint_as_float(rr[1]); }
    l_reg = l_reg * alpha + ps;
#define PK4(P, B_, OUT) do { unsigned a0 = cvtpk(P[B_+0], P[B_+1]), a1 = cvtpk(P[B_+2], P[B_+3]);                          \
        unsigned b0 = cvtpk(P[B_+4], P[B_+5]), b1 = cvtpk(P[B_+6], P[B_+7]);                                             \
        auto r0 = __builtin_amdgcn_permlane32_swap(a0, b0, false, false); auto r1 = __builtin_amdgcn_permlane32_swap(a1, b1, false, false); \
        u32x4 w = {r0[0], r1[0], r0[1], r1[1]}; OUT = __builtin_bit_cast(bf16x8, w); } while (0)
    PK4(p0, 0, pa0); PK4(p0, 8, pa1); PK4(p1, 0, pa2); PK4(p1, 8, pa3);
#undef PK4
}
template <int KB>
__device__ __forceinline__ void qkt(f32x16& p0, f32x16& p1, const LAS unsigned char* K_lds, int r32, int hi, const bf16x8* qr, const LAS unsigned char* qrl) {
    p0 = f32x16{}; p1 = f32x16{};
    const unsigned kb0 = (unsigned)(size_t)(K_lds + KB * SHM_K) + (unsigned)KSWZ(r32, hi * 16);
    const int f = (r32 >> 1) & 7;
    const LAS unsigned char* krp = K_lds + KB * SHM_K + 16384 + r32 * 128;
#define KLD(d0, h) ((d0) < 8 ? *(const LAS bf16x8*)((size_t)(kb0 ^ (unsigned)((d0) << 5)) + (h) * 32 * 256) \
                             : *(const LAS bf16x8*)(krp + (((((d0) - 8) * 2 + hi) ^ f) << 4) + (h) * 32 * 128))
#define QLD(d0) (*(const LAS bf16x8*)(qrl + (((((d0) - 8) * 2 + hi) ^ f) << 4)))
    bf16x8 ka00, ka01, ka10, ka11, qa0, qa1;
    ka00 = KLD(0, 0); ka01 = KLD(0, 1); ka10 = KLD(1, 0); ka11 = KLD(1, 1);
    __builtin_amdgcn_sched_group_barrier(0x100, 4, 0);
#define QSTEP(d0, A0, A1, QV, NRD) do { \
        p0 = __builtin_amdgcn_mfma_f32_32x32x16_bf16(A0, QV, p0, 0, 0, 0); \
        p1 = __builtin_amdgcn_mfma_f32_32x32x16_bf16(A1, QV, p1, 0, 0, 0); \
        if ((d0) + 2 < 12) { A0 = KLD((d0) + 2, 0); A1 = KLD((d0) + 2, 1); } \
        __builtin_amdgcn_sched_group_barrier(0x008, 2, 0); \
        if ((NRD) > 0) __builtin_amdgcn_sched_group_barrier(0x100, NRD, 0); } while (0)
    QSTEP(0, ka00, ka01, qr[0], 2); QSTEP(1, ka10, ka11, qr[1], 2); QSTEP(2, ka00, ka01, qr[2], 2); QSTEP(3, ka10, ka11, qr[3], 2);
    QSTEP(4, ka00, ka01, qr[4], 2); QSTEP(5, ka10, ka11, qr[5], 2);
    qa0 = QLD(8); QSTEP(6, ka00, ka01, qr[6], 3);
    qa1 = QLD(9); QSTEP(7, ka10, ka11, qr[7], 3);
    { const bf16x8 q8 = qa0; qa0 = QLD(10); QSTEP(8, ka00, ka01, q8, 3); }
    { const bf16x8 q9 = qa1; qa1 = QLD(11); QSTEP(9, ka10, ka11, q9, 3); }
    QSTEP(10, ka00, ka01, qa0, 0); QSTEP(11, ka10, ka11, qa1, 0);
#undef QSTEP
#undef KLD
#undef QLD
}
template <int VB>
__device__ __forceinline__ void pv_tile(f32x16* o, int vb0, bf16x8 pa0, bf16x8 pa1, bf16x8 pa2, bf16x8 pa3) {
#define TRRD(dst, off) asm volatile("ds_read_b64_tr_b16 %0, %1 offset:%2" : "=&v"(dst) : "v"(vb0), "i"(off) : "memory")
#define PV_RD(S, d0) do { constexpr int b_ = VB * SHM_V + v_rd_off(d0, 0, 0); \
        TRRD(S##l0, b_); TRRD(S##h0, b_ + 2048); TRRD(S##l1, b_ + 4096); TRRD(S##h1, b_ + 6144); TRRD(S##l2, b_ + 8192); TRRD(S##h2, b_ + 10240); TRRD(S##l3, b_ + 12288); TRRD(S##h3, b_ + 14336); } while (0)
#define PV_MM(S, d0) do { \
        o[d0] = __builtin_amdgcn_mfma_f32_32x32x16_bf16(pa0, (bf16x8){S##l0[0], S##l0[1], S##l0[2], S##l0[3], S##h0[0], S##h0[1], S##h0[2], S##h0[3]}, o[d0], 0, 0, 0);   \
        o[d0] = __builtin_amdgcn_mfma_f32_32x32x16_bf16(pa1, (bf16x8){S##l1[0], S##l1[1], S##l1[2], S##l1[3], S##h1[0], S##h1[1], S##h1[2], S##h1[3]}, o[d0], 0, 0, 0);   \
        o[d0] = __builtin_amdgcn_mfma_f32_32x32x16_bf16(pa2, (bf16x8){S##l2[0], S##l2[1], S##l2[2], S##l2[3], S##h2[0], S##h2[1], S##h2[2], S##h2[3]}, o[d0], 0, 0, 0);   \
        o[d0] = __builtin_amdgcn_mfma_f32_32x32x16_bf16(pa3, (bf16x8){S##l3[0], S##l3[1], S##l3[2], S##l3[3], S##h3[0], S##h3[1], S##h3[2], S##h3[3]}, o[d0], 0, 0, 0); } while (0)
#define PV_WAIT(N, S) asm volatile("s_waitcnt lgkmcnt(" #N ")" : "+v"(S##l0), "+v"(S##h0), "+v"(S##l1), "+v"(S##h1), "+v"(S##l2), "+v"(S##h2), "+v"(S##l3), "+v"(S##h3) :: "memory")
    s16x4 Al0, Al1, Al2, Al3, Ah0, Ah1, Ah2, Ah3, Bl0, Bl1, Bl2, Bl3, Bh0, Bh1, Bh2, Bh3;
    PV_RD(A, 0); PV_RD(B, 1);
    PV_WAIT(8, A); SBAR(); PV_MM(A, 0); SBAR();
    PV_RD(A, 2);
    PV_WAIT(8, B); SBAR(); PV_MM(B, 1); SBAR();
    PV_RD(B, 3);
    PV_WAIT(8, A); SBAR(); PV_MM(A, 2); SBAR();
    PV_WAIT(0, B); SBAR(); PV_MM(B, 3);
#undef PV_RD
#undef PV_MM
#undef PV_WAIT
#undef TRRD
}

__device__ __forceinline__ void attn_unit(const int wave_, int h, int qb, unsigned char* ws, unsigned wsQ, unsigned wsK, unsigned wsV, unsigned wsO, LAS unsigned char* lds) {
    const int wid = wave_, lane = lane_id(), r32 = lane & 31, hi = lane >> 5;
    LAS unsigned char* V_lds = lds + LDS_V; LAS unsigned char* K_lds = lds + LDS_K;
    LAS float* wsf = (LAS float*)(lds + LDS_WS) + wid * 64; LAS float* li_l = wsf; LAS float* al_l = wsf + 32;
    const int NTT = 4 * qb + 5;
    const int qlo = qb * 256 + wid * 32, qrow = qlo + r32;
    const int vb0 = (int)(size_t)V_lds + v_rd_base(lane);
    unsigned kn_off[2], v_off[2], kr_off;
#pragma unroll
    for (int j = 0; j < 2; ++j) { const int piece = j * 8 + wid;
        { const int row = piece * 4 + (lane >> 4), c = (lane & 15) ^ (row & 15); kn_off[j] = (unsigned)(row * QKD + c * 8) * 2u; }
        { const int sub = piece * 2 + (lane >> 5), kk = (sub >> 2) * 8 + ((lane & 31) >> 2), k = (kk & ~0xC) | ((kk & 4) << 1) | ((kk & 8) >> 1); v_off[j] = (unsigned)(k * VD + (sub & 3) * 32 + (lane & 3) * 8) * 2u; } }
    { const int row = wid * 8 + (lane >> 3), c = (lane & 7) ^ ((row >> 1) & 7); kr_off = (unsigned)(row * QKD + 128 + c * 8) * 2u; }
    LAS unsigned char* ldsA = lds;
#define KVROW(tt) ((tt) == 0 ? SEQ : ((tt) - 1) * 64)
#define SLOAD(tt, bf) do { const unsigned char* kp_ = ws + (wsK + (unsigned)(h * KROWS + KVROW(tt)) * (QKD * 2u)); const unsigned char* vp_ = ws + (wsV + (unsigned)(h * KROWS + KVROW(tt)) * (VD * 2u)); \
        _Pragma("unroll") for (int j_ = 0; j_ < 2; ++j_) { \
            __builtin_amdgcn_global_load_lds((const unsigned*)(kp_ + kn_off[j_]), (LAS unsigned*)(ldsA + LDS_K + (bf) * SHM_K + (j_ * 8 + wid) * 1024), 16, 0, 0); \
            __builtin_amdgcn_global_load_lds((const unsigned*)(vp_ + v_off[j_]), (LAS unsigned*)(ldsA + LDS_V + (bf) * SHM_V + (j_ * 8 + wid) * 1024), 16, 0, 0); } \
        __builtin_amdgcn_global_load_lds((const unsigned*)(kp_ + kr_off), (LAS unsigned*)(ldsA + LDS_K + (bf) * SHM_K + 16384 + wid * 1024), 16, 0, 0); } while (0)
    SLOAD(0, 0);
    bf16x8 qr[8];
    LAS unsigned char* qrl = lds + LDS_QR + wid * 4096 + r32 * 128;
    { const bf16_t* Qw = (const bf16_t*)(ws + wsQ) + ((size_t)h * SEQ + qrow) * QKD + hi * 8;
#pragma unroll
      for (int d0 = 0; d0 < 8; ++d0) qr[d0] = *(const bf16x8*)(Qw + d0 * 16);
      const int f_ = (r32 >> 1) & 7;
#pragma unroll
      for (int dd = 0; dd < 4; ++dd) { const bf16x8 t = *(const bf16x8*)(Qw + 128 + dd * 16); *(LAS bf16x8*)(qrl + (((dd * 2 + hi) ^ f_) << 4)) = t; } }
    asm volatile("s_waitcnt vmcnt(0)" ::: "memory");
    __syncthreads();
    float m_reg = -1e30f, l_reg = 0.f; f32x16 o[4] = {};
    f32x16 p0, p1; bf16x8 pa0, pa1, pa2, pa3;
#define STEP(tt, KB) do { \
        if ((tt) + 1 < NTT) SLOAD((tt) + 1, (KB) ^ 1); \
        const int kbase_ = ((tt) - 1) * 64; \
        const bool act_ = (tt) == 0 || kbase_ <= qlo + 31;               \
        if (act_) { \
            SBAR(); qkt<KB>(p0, p1, K_lds, r32, hi, qr, qrl); \
            if ((tt) == 0) mask_meta(p0, p1); else if (kbase_ + 63 > qlo) mask_causal(p0, p1, qrow - kbase_ - 4 * hi); \
            float alpha_; partialSM(p0, p1, m_reg, alpha_); \
            if (__any(alpha_ < 1.f)) { if (hi == 0) al_l[r32] = alpha_; asm volatile("s_waitcnt lgkmcnt(0)" ::: "memory"); \
                _Pragma("unroll") for (int d_ = 0; d_ < 4; ++d_) _Pragma("unroll") for (int r = 0; r < 16; ++r) o[d_][r] *= al_l[crow(r, hi)]; } \
            finishSM(p0, p1, alpha_, l_reg, pa0, pa1, pa2, pa3); SBAR(); \
            pv_tile<KB>(o, vb0, pa0, pa1, pa2, pa3); \
        } \
        asm volatile("s_waitcnt vmcnt(0)" ::: "memory"); \
        __syncthreads(); } while (0)
    int tt = 0;
    for (; tt + 1 < NTT; tt += 2) { STEP(tt, 0); STEP(tt + 1, 1); }
    STEP(tt, 0);
    if (hi == 0) li_l[r32] = l_reg;
    asm volatile("s_waitcnt lgkmcnt(0)" ::: "memory");
    bf16_t* Ow = (bf16_t*)(ws + wsO) + (size_t)qlo * D + h * VD;
#pragma unroll
    for (int r = 0; r < 16; ++r) { const int orow = crow(r, hi); const float rl = __builtin_amdgcn_rcpf(li_l[orow]);
#pragma unroll
        for (int d0 = 0; d0 < 4; ++d0) { const float v = o[d0][r] * rl; const float vn = __shfl_xor(v, 1);
            if ((r32 & 1) == 0) *(unsigned*)(Ow + (size_t)orow * D + d0 * 32 + r32) = cvtpk(v, vn); } }
    __syncthreads();
#undef STEP
#undef SLOAD
#undef KVROW
}
#undef KSWZ
#undef SBAR
}}
#define MK_BPOL "sc0 sc1 nt"
#ifndef MK_MOE_RELAX
#define MK_MOE_RELAX 1
#endif
#ifndef MK_BDEPTH3
#define MK_BDEPTH3 0
#endif
namespace mk { namespace m4 {
constexpr int ROWS = 384, A_ST = ROWS * 64, RAW_ST = 16384, IMG_ST = 8192, NRAW = 4;
constexpr int LDS_A = 0, LDS_RAW = 3 * A_ST, LDS_IMG = LDS_RAW + NRAW * RAW_ST, LDS_TOTAL = LDS_IMG + 2 * IMG_ST;
__device__ __forceinline__ int invperm32(int c) { return 16 * ((c >> 2) & 1) + 4 * (c >> 3) + (c & 3); }
__device__ __forceinline__ int swz(int ob) { return ob ^ (((ob >> 9) & 1) << 5); }
struct MUnit { const char* A; const float* B0; const float* B1; int nK; int pm, aux, ns, koff; };
struct UState { const char* asrc; const char* bsrc; unsigned voffA[3]; int wact; };
template <int MODE, class Sched, class Epi, int ABL = 0>
__device__ __forceinline__ void moe_phase(const int wave_, LAS unsigned char* lds, const Sched& S, const Epi& E, const float* kscale) {
    (void)kscale;
    const int wid = wave_, lane = lane_id(), tid = wid * 64 + lane, fr = lane & 15, fq = lane >> 4;
    constexpr int LDB = MODE == 0 ? 512 : 2048;
    constexpr int LDA = MODE == 0 ? 4096 : 1024;
    const unsigned ldsb = (unsigned)(size_t)lds;
    const int ob_ = swz(lane * 16), arr = ob_ >> 6, acc8 = (ob_ & 63) >> 1;
    unsigned voffB[2];
#pragma unroll
    for (int q = 0; q < 2; ++q) voffB[q] = MODE == 0 ? (unsigned)(((8 * (wid & 3) + 4 * q + (lane >> 4)) * LDB + 4 * (lane & 15)) * 4) : (unsigned)(((4 * wid + 2 * q + (lane >> 5)) * LDB + 4 * (lane & 31)) * 4);
    const int which = MODE == 0 ? (wid >> 2) : 0;
    const int bk4 = MODE == 0 ? 2 * (wid & 3) + (lane >> 5) : wid;
    const int bcol = MODE == 0 ? 2 * (lane & 31) : 2 * lane;
    const unsigned rawoff = MODE == 0 ? (unsigned)(which * 8192 + (bk4 * 4) * 256 + bcol * 4) : (unsigned)((bk4 * 4) * 512 + bcol * 4);
    constexpr int RAWP = MODE == 0 ? 256 : 512;
    unsigned bwoff[2];
#pragma unroll
    for (int jj = 0; jj < 2; ++jj) { const int n = MODE == 0 ? 2 * (bcol + jj) + which : bcol + jj; const int rho = (n & ~31) + invperm32(n & 31); bwoff[jj] = (unsigned)((rho >> 4) * 1024 + swz((rho & 15) * 64 + bk4 * 8)); }
    const int afoff = swz(fr * 64 + fq * 16);
#define M4_USTATE(US, U) do { (US).wact = (wid * 48 < (U).aux - (U).pm) ? 1 : 0; \
        _Pragma("unroll") for (int p_ = 0; p_ < 3; ++p_) { const int r_ = wid * 48 + p_ * 16 + arr; (US).voffA[p_] = ((ABL & 32) ? (unsigned)((r_ & 15) * LDA) : (MODE == 0 ? S.arow(U, r_) : (unsigned)(r_ * LDA))) + (unsigned)(acc8 * 2); } \
        { const unsigned long long bb_ = (unsigned long long)((MODE == 0 && wid >= 4) ? (U).B1 : (U).B0), aa_ = (unsigned long long)(U).A; \
          (US).bsrc = (const char*)(((unsigned long long)(unsigned)__builtin_amdgcn_readfirstlane((int)(bb_ >> 32)) << 32) | (unsigned)__builtin_amdgcn_readfirstlane((int)bb_)); \
          (US).asrc = (const char*)(((unsigned long long)(unsigned)__builtin_amdgcn_readfirstlane((int)(aa_ >> 32)) << 32) | (unsigned)__builtin_amdgcn_readfirstlane((int)aa_)); } } while (0)
#define M4_DMA(voff, dst, base, NT) do { unsigned keep_; const unsigned d_ = (unsigned)__builtin_amdgcn_readfirstlane((int)(dst)); \
        if (NT) asm volatile("s_mov_b32 %0, m0\n\ts_mov_b32 m0, %2\n\ts_nop 0\n\tglobal_load_lds_dwordx4 %1, %3 " MK_BPOL "\n\ts_mov_b32 m0, %0" : "=&s"(keep_) : "v"(voff), "s"(d_), "s"(base) : "memory"); \
        else asm volatile("s_mov_b32 %0, m0\n\ts_mov_b32 m0, %2\n\ts_nop 0\n\tglobal_load_lds_dwordx4 %1, %3\n\ts_mov_b32 m0, %0" : "=&s"(keep_) : "v"(voff), "s"(d_), "s"(base) : "memory"); } while (0)
#define M4_STAGEA(US, k, st) do { if (!(ABL & 4) && (US).wact) { const char* ab_ = (US).asrc + (size_t)(k) * 64; _Pragma("unroll") for (int p_ = 0; p_ < 3; ++p_) M4_DMA((US).voffA[p_], ldsb + LDS_A + (st) * A_ST + (3 * wid + p_) * 1024, ab_, 0); } } while (0)
#define M4_STAGEB(US, k, st) do { if (!(ABL & 2)) { const char* bb_ = (US).bsrc + (size_t)(k) * (32 * LDB * 4); _Pragma("unroll") for (int q_ = 0; q_ < 2; ++q_) M4_DMA(voffB[q_], ldsb + LDS_RAW + (st) * RAW_ST + (2 * wid + q_) * 1024, bb_, 1); } } while (0)
#define M4_CONVERT(st, buf) do { f32x2 r_[4]; _Pragma("unroll") for (int i_ = 0; i_ < 4; ++i_) r_[i_] = *(const LAS f32x2*)(lds + LDS_RAW + (st) * RAW_ST + rawoff + i_ * RAWP); \
        _Pragma("unroll") for (int jj_ = 0; jj_ < 2; ++jj_) { u32x2 w_; w_.x = cvtpk(r_[0][jj_], r_[1][jj_]); w_.y = cvtpk(r_[2][jj_], r_[3][jj_]); \
            *(LAS u32x2*)(lds + LDS_IMG + (buf) * IMG_ST + bwoff[jj_]) = w_; } } while (0)
#define M4_COMPUTE(st, buf) do { if (!(ABL & 1) && cur.wact) { bf16x8 Af[3], Bf[8]; \
        _Pragma("unroll") for (int m = 0; m < 3; ++m) Af[m] = *(const LAS bf16x8*)(lds + LDS_A + (st) * A_ST + (3 * wid + m) * 1024 + afoff); \
        _Pragma("unroll") for (int n = 0; n < 8; ++n) Bf[n] = *(const LAS bf16x8*)(lds + LDS_IMG + (buf) * IMG_ST + n * 1024 + afoff); \
        _Pragma("unroll") for (int m = 0; m < 3; ++m) _Pragma("unroll") for (int n = 0; n < 8; ++n) acc[m][n] = __builtin_amdgcn_mfma_f32_16x16x32_bf16(Bf[n], Af[m], acc[m][n], 0, 0, 0); } } while (0)
#define M4_COMPUTE_STAGE(st, buf, stg_, vo_, ab_) do { \
        const bool act_ = !(ABL & 1) && cur.wact; \
        bf16x8 Af[3], Bf[8]; \
        if (act_) { _Pragma("unroll") for (int m = 0; m < 3; ++m) Af[m] = *(const LAS bf16x8*)(lds + LDS_A + (st) * A_ST + (3 * wid + m) * 1024 + afoff); \
            _Pragma("unroll") for (int n = 0; n < 8; ++n) Bf[n] = *(const LAS bf16x8*)(lds + LDS_IMG + (buf) * IMG_ST + n * 1024 + afoff); } \
        asm volatile("s_waitcnt lgkmcnt(0)" ::: "memory");                        \
        _Pragma("unroll") for (int m = 0; m < 3; ++m) { \
            if (act_) { _Pragma("unroll") for (int n = 0; n < 8; ++n) acc[m][n] = __builtin_amdgcn_mfma_f32_16x16x32_bf16(Bf[n], Af[m], acc[m][n], 0, 0, 0); } \
            if (stg_) M4_DMA(vo_[m], ldsb + LDS_A + (st) * A_ST + (3 * wid + m) * 1024, ab_, 0); \
            __builtin_amdgcn_sched_barrier(0); } } while (0)
#define M4_WAITV(N) asm volatile("s_waitcnt vmcnt(" #N ")" ::: "memory")
#define M4_WAITDYN(n_) do { switch (n_) { case 7: M4_WAITV(7); break; case 8: M4_WAITV(8); break; case 10: M4_WAITV(10); break; case 11: M4_WAITV(11); break; case 12: M4_WAITV(12); break; \
        case 14: M4_WAITV(14); break; case 15: M4_WAITV(15); break; case 16: M4_WAITV(16); break; case 18: M4_WAITV(18); break; case 19: M4_WAITV(19); break; case 22: M4_WAITV(22); break; \
        default: M4_WAITV(4); break; } } while (0)
    MUnit ucur, unxt; UState cur, nxt;
    if (!S.next(0, ucur)) return;
    M4_USTATE(cur, ucur);
    const int nK = ucur.nK, kmask = nK - 1;
    bool has_next = S.next(1, unxt);
    if (has_next) M4_USTATE(nxt, unxt); else nxt = cur;
    int koffc = __builtin_amdgcn_readfirstlane(ucur.koff) & kmask, koffn = has_next ? (__builtin_amdgcn_readfirstlane(unxt.koff) & kmask) : 0;
    int sprev = 0;
    int a0 = 0, a1 = 1, a2 = 2, wa1 = cur.wact ? 3 : 0, wa2 = wa1;
    asm volatile("s_waitcnt vmcnt(0)" ::: "memory");
    M4_STAGEA(cur, (0 + koffc) & kmask, 0); M4_STAGEA(cur, (1 + koffc) & kmask, 1); M4_STAGEA(cur, (2 + koffc) & kmask, 2);
#pragma unroll
    for (int s_ = 0; s_ < (MK_BDEPTH3 ? 3 : 4); ++s_) M4_STAGEB(cur, (s_ + koffc) & kmask, s_);
    M4_WAITV(0);
    __builtin_amdgcn_s_barrier();
    M4_CONVERT(0, 0);
    asm volatile("s_waitcnt lgkmcnt(0)" ::: "memory"); __builtin_amdgcn_s_barrier();
    for (int ui = 0;; ++ui) {
        f32x4 acc[3][8];
#pragma unroll
        for (int m = 0; m < 3; ++m)
#pragma unroll
            for (int n = 0; n < 8; ++n) acc[m][n] = (f32x4){0.f, 0.f, 0.f, 0.f};
#define M4_STEP(t, PAR) do { \
            const bool in1_ = (t) + 1 < nK, in3_ = (t) + 3 < nK, in4_ = (t) + 4 < nK; \
            const int wq_ = wa1 + wa2; \
            if (in3_ || has_next) { if (!(ABL & 6)) { if (MK_BDEPTH3) { if (wq_ == 6) M4_WAITV(8); else if (wq_ == 3) M4_WAITV(5); else M4_WAITV(2); } \
                    else if (MK_MOE_RELAX && (t) < 3 && sprev != 0) { const int al_ = 4 + wq_ + sprev; M4_WAITDYN(al_); } \
                    else { if (wq_ == 6) M4_WAITV(10); else if (wq_ == 3) M4_WAITV(7); else M4_WAITV(4); } } \
                else if ((ABL & 6) == 4) M4_WAITV(4); else if ((ABL & 6) == 2) { if (wq_ == 6) M4_WAITV(6); else if (wq_ == 3) M4_WAITV(3); else M4_WAITV(0); } } \
            else M4_WAITV(0); \
            if ((in1_ || has_next) && !(ABL & 16)) M4_CONVERT(((t) + 1) & 3, 1 - (PAR)); \
            if (MK_BDEPTH3) { if (in3_) M4_STAGEB(cur, ((t) + 3 + koffc) & kmask, ((t) + 3) & 3); else if (has_next) M4_STAGEB(nxt, ((t) + 3 - nK + koffn) & kmask, ((t) + 3) & 3); } \
            else { if (in4_) M4_STAGEB(cur, ((t) + 4 + koffc) & kmask, (t) & 3); else if (has_next) M4_STAGEB(nxt, ((t) + 4 - nK + koffn) & kmask, (t) & 3); } \
            __builtin_amdgcn_sched_barrier(0); \
            const bool any3_ = in3_ || has_next;                                          \
            const int w3_ = any3_ ? (in3_ ? cur.wact : nxt.wact) : 0; \
            const int k3_ = in3_ ? (((t) + 3 + koffc) & kmask) : (((t) + 3 - nK + koffn) & kmask); \
            const char* ab3_ = (in3_ ? cur.asrc : nxt.asrc) + (size_t)k3_ * 64; \
            unsigned vo3_[3]; _Pragma("unroll") for (int p_ = 0; p_ < 3; ++p_) vo3_[p_] = in3_ ? cur.voffA[p_] : nxt.voffA[p_]; \
            const bool stg3_ = !(ABL & 4) && w3_ != 0; \
            M4_COMPUTE_STAGE(a0, PAR, stg3_, vo3_, ab3_); \
            __builtin_amdgcn_sched_barrier(0); \
            asm volatile("s_waitcnt lgkmcnt(0)" ::: "memory"); __builtin_amdgcn_s_barrier(); \
            { const int s_ = a0; a0 = a1; a1 = a2; a2 = s_; wa1 = wa2; wa2 = w3_ ? 3 : 0; } } while (0)
        for (int t = 0; t < nK; t += 2) { M4_STEP(t, 0); M4_STEP(t + 1, 1); }
#undef M4_STEP
        if (!(ABL & 8)) { if (cur.wact) E(acc, ucur, wid, fr, fq); } else { asm volatile("" :: "v"(acc[0][0]), "v"(acc[1][1]), "v"(acc[2][2])); }
        { int nm_ = 0;
#pragma unroll
          for (int m = 0; m < 3; ++m) nm_ += (ucur.pm + 48 * wid + 16 * m < ucur.aux) ? 1 : 0;
          sprev = (!(ABL & 8) && cur.wact) ? 4 * __builtin_amdgcn_readfirstlane(nm_) : 0; }
        if (!has_next) break;
        ucur = unxt; cur = nxt; koffc = koffn;
        has_next = S.next(ui + 2, unxt);
        if (has_next) { M4_USTATE(nxt, unxt); koffn = __builtin_amdgcn_readfirstlane(unxt.koff) & kmask; }
    }
    M4_WAITV(0);
    __syncthreads();
#undef M4_USTATE
#undef M4_DMA
#undef M4_STAGEA
#undef M4_STAGEB
#undef M4_CONVERT
#undef M4_COMPUTE
#undef M4_COMPUTE_STAGE
#undef M4_WAITV
#undef M4_WAITDYN
}
}}
namespace mk {
constexpr size_t MiB = 1u << 20;
constexpr size_t WS_CTL = 0, CTL_ZERO_BYTES = 1 * MiB;
constexpr size_t WS_WIN = 2 * MiB;
constexpr size_t WS_WQKV = 28 * MiB;
constexpr size_t WS_WO = 36 * MiB;
constexpr size_t WS_WPE = 44 * MiB;
constexpr size_t WS_WOUT = 52 * MiB;
constexpr size_t WS_WR = 60 * MiB;
constexpr size_t WS_ROPE = 61 * MiB;
constexpr size_t WS_XN = 64 * MiB;
constexpr size_t WS_XNM = 96 * MiB;
constexpr size_t WS_SSQ = 97 * MiB;
constexpr size_t WS_CQKV = 98 * MiB;
constexpr size_t WS_U = 116 * MiB;
constexpr size_t WS_G = 133 * MiB;
constexpr size_t WS_Q = 197 * MiB;
constexpr size_t WS_K = 245 * MiB;
constexpr size_t WS_V = 294 * MiB;
constexpr size_t WS_O = 327 * MiB;
constexpr size_t WS_PL = 359 * MiB;
constexpr size_t WS_SS2 = 391 * MiB;
constexpr size_t WS_RT = 393 * MiB;
constexpr size_t WS_WPOT = 396 * MiB;
constexpr size_t WS_PWB = 400 * MiB;
constexpr size_t WS_CQKV2 = 404 * MiB;
constexpr size_t WS_WQKV2 = 436 * MiB;
constexpr size_t WS_WED = 652 * MiB;
constexpr size_t WS_END = 780 * MiB;
constexpr int CW_BAR = 4096;
constexpr int WIN_ROWS = 6400;

constexpr int RING_BYTES = 155648, MISC_OFF = RING_BYTES, LDS_BYTES = 163840;

struct Args { const float* in[22]; float* out; unsigned char* ws; int ph_lo, ph_hi, never, pad; };

struct Frame {
    LAS unsigned char* lds; volatile LAS unsigned* MISC;
    int vcu, G, wave;
    unsigned char* ws;
};
struct Ids { int tid, lane, wave; };
__device__ __forceinline__ Ids phase_ids(int wave) { Ids i; i.wave = wave; i.lane = lane_id(); i.tid = wave * 64 + i.lane; return i; }

enum { MAP_ID = 0, MAP_WIN = 1, MAP_UQ = 2, MAP_EVEN = 3, MAP_ODD = 4 };
__device__ __forceinline__ int ileave64(int i) { return i < 32 ? 2 * i : 2 * (i - 32) + 1; }
template <int KIND> __device__ __forceinline__ int map_row(int n) {
    if (KIND == MAP_WIN) { if (n < 1024) return n; if (n < 1088) return 6144 + ileave64(n - 1024); return n - 64; }
    if (KIND == MAP_UQ) { const int h = n / 192, d = n - h * 192; return d < 128 ? n : h * 192 + 128 + ileave64(d - 128); }
    if (KIND == MAP_EVEN) return 2 * n;
    if (KIND == MAP_ODD) return 2 * n + 1;
    return n;
}
template <int KIND> __device__ __forceinline__ void tile_store_T(const LAS float* scr, bf16_t* WT, int ldt, int row_off, int n0, int k0, int lane) {
    const int c = lane & 7;
#pragma unroll
    for (int j = 0; j < 4; ++j) { const int n = (lane >> 3) + 8 * j; const LAS float* s = scr + (8 * c) * 33 + n;
        u32x4 o; o.x = cvtpk(s[0 * 33], s[1 * 33]); o.y = cvtpk(s[2 * 33], s[3 * 33]); o.z = cvtpk(s[4 * 33], s[5 * 33]); o.w = cvtpk(s[6 * 33], s[7 * 33]);
        *(u32x4*)(WT + (size_t)(row_off + map_row<KIND>(n0 + n)) * ldt + k0 + 8 * c) = o; }
    asm volatile("s_waitcnt lgkmcnt(0)" ::: "memory");
}
template <int KIND> __device__ __forceinline__ void p0_transpose_item(const float* W, int N, bf16_t* WT, int ldt, int row_off, const float* kscale, LAS float* scr, int item, int lane) {
    const int nblk = N / 32, kb = item / nblk, nb = item % nblk, k0 = 64 * kb, n0 = 32 * nb;
    float tv[32];
#pragma unroll
    for (int i = 0; i < 32; ++i) { const int kk = 2 * i + (lane >> 5); tv[i] = W[(size_t)(k0 + kk) * N + n0 + (lane & 31)]; }
#pragma unroll
    for (int i = 0; i < 32; ++i) { const int kk = 2 * i + (lane >> 5); float v = tv[i]; if (kscale) v *= kscale[k0 + kk]; scr[kk * 33 + (lane & 31)] = v; }
    asm volatile("s_waitcnt lgkmcnt(0)" ::: "memory");
    tile_store_T<KIND>(scr, WT, ldt, row_off, n0, k0, lane);
}
__device__ __forceinline__ void rms_row_to_bf16(const float* xrow, const float* w, bf16_t* orow, int lane) {
    const f32x4* xr = (const f32x4*)xrow + lane; const f32x4* wr4 = (const f32x4*)w + lane;
    f32x4 v[8]; float s = 0.f;
#pragma unroll
    for (int j = 0; j < 8; ++j) { v[j] = xr[64 * j]; s += (v[j].x * v[j].x + v[j].y * v[j].y) + (v[j].z * v[j].z + v[j].w * v[j].w); }
    const float rstd = rsqrtf(wave_sum(s) * (1.f / D) + EPS);
    u32x2* o8 = (u32x2*)orow + lane;
#pragma unroll
    for (int j = 0; j < 8; ++j) { const f32x4 ww = wr4[64 * j]; u32x2 o; o.x = cvtpk(v[j].x * rstd * ww.x, v[j].y * rstd * ww.y); o.y = cvtpk(v[j].z * rstd * ww.z, v[j].w * rstd * ww.w); o8[64 * j] = o; }
}

__device__ __forceinline__ void rms_row2_to_bf16(const float* x0, const float* x1, const float* w, bf16_t* o0, bf16_t* o1, int lane) {
    const f32x4* xr0 = (const f32x4*)x0 + lane; const f32x4* xr1 = (const f32x4*)x1 + lane; const f32x4* wr4 = (const f32x4*)w + lane;
    f32x4 a[8], b[8]; float s0 = 0.f, s1 = 0.f;
#pragma unroll
    for (int j = 0; j < 8; ++j) { a[j] = xr0[64 * j]; b[j] = xr1[64 * j]; }
#pragma unroll
    for (int j = 0; j < 8; ++j) { s0 += (a[j].x * a[j].x + a[j].y * a[j].y) + (a[j].z * a[j].z + a[j].w * a[j].w); s1 += (b[j].x * b[j].x + b[j].y * b[j].y) + (b[j].z * b[j].z + b[j].w * b[j].w); }
    const float r0 = rsqrtf(wave_sum(s0) * (1.f / D) + EPS), r1 = rsqrtf(wave_sum(s1) * (1.f / D) + EPS);
    u32x2* p0 = (u32x2*)o0 + lane; u32x2* p1 = (u32x2*)o1 + lane;
#pragma unroll
    for (int j = 0; j < 8; ++j) { const f32x4 ww = wr4[64 * j]; u32x2 o; o.x = cvtpk(a[j].x * r0 * ww.x, a[j].y * r0 * ww.y); o.y = cvtpk(a[j].z * r0 * ww.z, a[j].w * r0 * ww.w); p0[64 * j] = o;
        u32x2 q; q.x = cvtpk(b[j].x * r1 * ww.x, b[j].y * r1 * ww.y); q.y = cvtpk(b[j].z * r1 * ww.z, b[j].w * r1 * ww.w); p1[64 * j] = q; }
}
__device__ __forceinline__ void p0_prologue(Frame& F, const Args& a) {
    const Ids I = phase_ids(F.wave);
    LAS float* scr = (LAS float*)(F.lds + I.wave * 16384);
    const int gw = F.vcu * NWAVES + I.wave, NGW = F.G * NWAVES, lane = I.lane;
    unsigned char* ws = F.ws;
    bf16_t* WIN = (bf16_t*)(ws + WS_WIN); bf16_t* WQKV = (bf16_t*)(ws + WS_WQKV2);
    constexpr int I_IN = 32 * (6208 / 32), I_UQ = 8 * (3072 / 32), I_UKV = 8 * (4096 / 32), I_O = 32 * 64, I_OUT = 32 * 64, I_RE = 32 * 2, I_WEFF = 16 * 64;
    constexpr int NITEMS = I_IN + I_UQ + I_UKV + I_O + I_OUT + I_RE + I_WEFF;
    for (int it = gw; it < NITEMS; it += NGW) {
        int r = it;
        if (r < I_IN) { p0_transpose_item<MAP_WIN>(a.in[3], 6208, WIN, 2048, 0, nullptr, scr, r, lane); continue; } r -= I_IN;
        if (r < I_UQ) { p0_transpose_item<MAP_UQ>(a.in[5], 3072, WQKV, 2048, 0, a.in[4], scr, r, lane); continue; } r -= I_UQ;
        if (r < I_UKV) { p0_transpose_item<MAP_ID>(a.in[7], 4096, WQKV, 2048, 3072, a.in[6], scr, r, lane); continue; } r -= I_UKV;
        if (r < I_O) { p0_transpose_item<MAP_ID>(a.in[8], 2048, (bf16_t*)(ws + WS_WO), 2048, 0, nullptr, scr, r, lane); continue; } r -= I_O;
        if (r < I_OUT) { p0_transpose_item<MAP_ID>(a.in[12], 2048, (bf16_t*)(ws + WS_WOUT), 2048, 0, nullptr, scr, r, lane); continue; } r -= I_OUT;
        if (r < I_RE) { p0_transpose_item<MAP_ID>(a.in[16], 64, (bf16_t*)(ws + WS_WR), 2048, 8, nullptr, scr, r, lane); continue; } r -= I_RE;
        p0_transpose_item<MAP_ID>(a.in[11], 2048, (bf16_t*)(ws + WS_WPOT), 1024, 0, a.in[10], scr, r, lane);
    }
    { const int gt = gw * 64 + lane, NT = NGW * 64; bf16_t* WR = (bf16_t*)(ws + WS_WR);
      for (int i = gt; i < 8 * 2048; i += NT) { const int n = i >> 11, k = i & 2047; WR[(size_t)n * 2048 + k] = f2bf(a.in[14][(size_t)k * 8 + n]); }
      for (int i = gt; i < (128 - 72) * 2048; i += NT) WR[(size_t)72 * 2048 + i] = 0;
      { bf16_t* PWB = (bf16_t*)(ws + WS_PWB); for (int i = gt; i < 4 * 256 * 256 / 4; i += NT) { const f32x4 v = *(const f32x4*)(a.in[9] + (size_t)i * 4); u32x2 o; o.x = cvtpk(v[0], v[1]); o.y = cvtpk(v[2], v[3]); *(u32x2*)(PWB + (size_t)i * 4) = o; } }
      u32x4* z = (u32x4*)(WIN + (size_t)6208 * 2048);
      for (int i = gt; i < (WIN_ROWS - 6208) * 2048 * 2 / 16; i += NT) z[i] = (u32x4){0u, 0u, 0u, 0u};
      bf16_t* Kb = (bf16_t*)(ws + WS_K); bf16_t* Vb = (bf16_t*)(ws + WS_V);
      for (int i = gt; i < NH * 48 * QKD / 8; i += NT) { const int h = i / (48 * QKD / 8), r = i % (48 * QKD / 8); *(u32x4*)(Kb + ((size_t)h * KROWS + 8208) * QKD + (size_t)r * 8) = (u32x4){0u, 0u, 0u, 0u}; }
      for (int i = gt; i < NH * 48 * VD / 8; i += NT) { const int h = i / (48 * VD / 8), r = i % (48 * VD / 8); *(u32x4*)(Vb + ((size_t)h * KROWS + 8208) * VD + (size_t)r * 8) = (u32x4){0u, 0u, 0u, 0u}; }
      f32x2* RT = (f32x2*)(ws + WS_ROPE);
      for (int i = gt; i < LTOT * 32; i += NT) { const int pos = i >> 5, ii = i & 31; float s, c; sincosf((float)pos * (1.0f / powf(10000.f, (float)(2 * ii) / 64.f)), &s, &c); RT[i] = (f32x2){c, s}; }
    }
    for (int m = gw; m < SEQ + NMETA; m += NGW) {
        if (m < SEQ) rms_row_to_bf16(a.in[0] + (size_t)m * D, a.in[2], (bf16_t*)(ws + WS_XN) + (size_t)m * D, lane);
        else rms_row_to_bf16(a.in[1] + (size_t)(m - SEQ) * D, a.in[2], (bf16_t*)(ws + WS_XNM) + (size_t)(m - SEQ) * D, lane);
    }
}

__device__ __forceinline__ void meta_stage1(Frame& F) {
    const Ids I = phase_ids(F.wave);
    const int item = blockIdx.x * NWAVES + I.wave; if (item >= 100) return;
    unsigned char* ws = F.ws; const int lane = I.lane, c16 = lane & 15, q4 = lane >> 4;
    const int nb = item < 32 ? 512 + 16 * item : (item < 96 ? 1024 + 16 * (item - 32) : 6144 + 16 * (item - 96));
    const bf16_t* Ap = (const bf16_t*)(ws + WS_XNM) + (size_t)c16 * D + 8 * q4;
    const bf16_t* Bp = (const bf16_t*)(ws + WS_WIN) + (size_t)(nb + c16) * D + 8 * q4;
    f32x4 acc = {0.f, 0.f, 0.f, 0.f};
#pragma unroll 16
    for (int ks = 0; ks < 64; ++ks) { const bf16x8 av = *(const bf16x8*)(Ap + 32 * ks), bv = *(const bf16x8*)(Bp + 32 * ks); acc = __builtin_amdgcn_mfma_f32_16x16x32_bf16(av, bv, acc, 0, 0, 0); }
    if (item < 32) { float* CK = (float*)(ws + WS_XNM + 65536);
#pragma unroll
        for (int r = 0; r < 4; ++r) CK[(4 * q4 + r) * 512 + 16 * item + c16] = acc[r]; }
    else if (item < 96) { bf16_t* U = (bf16_t*)(ws + WS_U);
#pragma unroll
        for (int r = 0; r < 4; ++r) U[(size_t)(4 * q4 + r) * 1024 + 16 * (item - 32) + c16] = f2bf(acc[r]); }
    else { const int col = 16 * (item - 96) + c16, ii = col >> 1; const f32x2* RT = (const f32x2*)(ws + WS_ROPE); bf16_t* Kb = (bf16_t*)(ws + WS_K);
#pragma unroll
        for (int r = 0; r < 4; ++r) { const int row = 4 * q4 + r; const float own = acc[r], oth = __shfl_xor(own, 1); const f32x2 cs = RT[row * 32 + ii];
            const float y = (col & 1) ? (oth * cs.y + own * cs.x) : (own * cs.x - oth * cs.y); const bf16_t yb = f2bf(y);
            for (int h = 0; h < NH; ++h) Kb[((size_t)h * KROWS + SEQ + row) * QKD + 128 + col] = yb; } }
}


__device__ __forceinline__ void weff_stage(Frame& F) {
    const Ids I = phase_ids(F.wave); unsigned char* ws = F.ws; const int lane = I.lane, c16 = lane & 15, q4 = lane >> 4;
    const bf16_t* PWB = (const bf16_t*)(ws + WS_PWB); const bf16_t* WPOT = (const bf16_t*)(ws + WS_WPOT); bf16_t* WPE = (bf16_t*)(ws + WS_WPE);
    for (int item = F.vcu * NWAVES + I.wave; item < 4 * 16 * 128; item += F.G * NWAVES) { const int nb = item & 127, cb = (item >> 7) & 15, g = item >> 11;
        const bf16_t* Ap = PWB + ((size_t)g * 256 + cb * 16 + c16) * 256 + 8 * q4;
        const bf16_t* Bp = WPOT + (size_t)(nb * 16 + c16) * 1024 + g * 256 + 8 * q4;
        f32x4 acc = {0.f, 0.f, 0.f, 0.f};
#pragma unroll
        for (int ks = 0; ks < 8; ++ks) { const bf16x8 av = *(const bf16x8*)(Ap + 32 * ks), bv = *(const bf16x8*)(Bp + 32 * ks); acc = __builtin_amdgcn_mfma_f32_16x16x32_bf16(av, bv, acc, 0, 0, 0); }
        u32x2 o; o.x = cvtpk(acc[0], acc[1]); o.y = cvtpk(acc[2], acc[3]);
        *(u32x2*)(WPE + (size_t)(nb * 16 + c16) * 2048 + g * 256 + cb * 16 + 4 * q4) = o; }
}
struct SchedP1 { pg8::TileOrder T; const char* A; const char* B;
    __device__ __forceinline__ bool next(int i, pg8::GUnit& u) const { int pm, pn; if (!T.tile(i, pm, pn)) return false; u.pm = pm; u.pn = pn; u.aux = 0; u.nt = 32; u.A = A + (size_t)pm * 256 * 4096; u.B = B + (size_t)pn * 256 * 4096; return true; } };
struct EpiP1 {
    bf16_t* CQKV; float* SSQ; bf16_t* U; bf16_t* G; bf16_t* Kb; const f32x2* RT;
    __device__ __forceinline__ int nstores(const pg8::GUnit& u) const { return u.pn < 24 ? 16 : 0; }
    __device__ __forceinline__ void operator()(const f32x4 (&acc)[2][2][4][2], const pg8::GUnit& u, int wr, int wc, int fr, int fq) const {
        const int pn = u.pn, row0 = u.pm * 256 + wr * 64 + fr;
        if (pn < 4) {
#pragma unroll
            for (int ai = 0; ai < 2; ++ai)
#pragma unroll
                for (int m = 0; m < 4; ++m) { const int r = row0 + ai * 128 + m * 16;
#pragma unroll
                    for (int bj = 0; bj < 2; ++bj) { const f32x4 v0 = acc[ai][bj][m][0], v1 = acc[ai][bj][m][1];
                        u32x4 w; w.x = cvtpk(v0[0], v0[1]); w.y = cvtpk(v0[2], v0[3]); w.z = cvtpk(v1[0], v1[1]); w.w = cvtpk(v1[2], v1[3]);
                        *(u32x4*)(CQKV + (size_t)r * 2048 + pn * 256 + bj * 128 + wc * 32 + 8 * fq) = w;
                        float s = (v0[0] * v0[0] + v0[1] * v0[1]) + (v0[2] * v0[2] + v0[3] * v0[3]) + (v1[0] * v1[0] + v1[1] * v1[1]) + (v1[2] * v1[2] + v1[3] * v1[3]);
                        s += __shfl_xor(s, 16); s += __shfl_xor(s, 32);
                        if (fq == 0) SSQ[((size_t)(pn >> 1) * SEQ + r) * 16 + (pn & 1) * 8 + bj * 4 + wc] = s; } }
        } else if (pn < 8) {
#pragma unroll
            for (int ai = 0; ai < 2; ++ai)
#pragma unroll
                for (int m = 0; m < 4; ++m) { const int r = row0 + ai * 128 + m * 16;
#pragma unroll
                    for (int bj = 0; bj < 2; ++bj) { const f32x4 v0 = acc[ai][bj][m][0], v1 = acc[ai][bj][m][1];
                        u32x4 w; w.x = cvtpk(v0[0], v0[1]); w.y = cvtpk(v0[2], v0[3]); w.z = cvtpk(v1[0], v1[1]); w.w = cvtpk(v1[2], v1[3]);
                        *(u32x4*)(U + (size_t)(NMETA + r) * 1024 + (pn - 4) * 256 + bj * 128 + wc * 32 + 8 * fq) = w; } }
        } else if (pn < 24) {
#pragma unroll
            for (int ai = 0; ai < 2; ++ai)
#pragma unroll
                for (int m = 0; m < 4; ++m) { const int r = row0 + ai * 128 + m * 16;
#pragma unroll
                    for (int bj = 0; bj < 2; ++bj) { const f32x4 v0 = acc[ai][bj][m][0], v1 = acc[ai][bj][m][1];
                        u32x4 w; w.x = cvtpk(sigmoidf_(v0[0]), sigmoidf_(v0[1])); w.y = cvtpk(sigmoidf_(v0[2]), sigmoidf_(v0[3])); w.z = cvtpk(sigmoidf_(v1[0]), sigmoidf_(v1[1])); w.w = cvtpk(sigmoidf_(v1[2]), sigmoidf_(v1[3]));
                        *(u32x4*)(G + (size_t)r * 4096 + (pn - 8) * 256 + bj * 128 + wc * 32 + 8 * fq) = w; } }
        } else {
            if (wc < 2) {
                const int colr = wc * 32 + 8 * fq, i0 = colr >> 1;
#pragma unroll
                for (int ai = 0; ai < 2; ++ai)
#pragma unroll
                    for (int m = 0; m < 4; ++m) { const int r = row0 + ai * 128 + m * 16; const f32x4 v0 = acc[ai][0][m][0], v1 = acc[ai][0][m][1];
                        const f32x4 cs0 = *(const f32x4*)(RT + (size_t)(r + NMETA) * 32 + i0), cs1 = *(const f32x4*)(RT + (size_t)(r + NMETA) * 32 + i0 + 2);
                        u32x4 w; w.x = cvtpk(v0[0] * cs0[0] - v0[1] * cs0[1], v0[0] * cs0[1] + v0[1] * cs0[0]); w.y = cvtpk(v0[2] * cs0[2] - v0[3] * cs0[3], v0[2] * cs0[3] + v0[3] * cs0[2]);
                        w.z = cvtpk(v1[0] * cs1[0] - v1[1] * cs1[1], v1[0] * cs1[1] + v1[1] * cs1[0]); w.w = cvtpk(v1[2] * cs1[2] - v1[3] * cs1[3], v1[2] * cs1[3] + v1[3] * cs1[2]);
#pragma unroll
                        for (int h = 0; h < NH; ++h) *(u32x4*)(Kb + ((size_t)h * KROWS + r) * QKD + 128 + colr) = w; }
            }
        }
    }
};


template <int W> __device__ __forceinline__ void pool_strip(const bf16_t* U, bf16_t* PL, int p0, int c0) {
    u32x4 v[W + 7];
#pragma unroll
    for (int j = 0; j < W + 7; ++j) v[j] = *(const u32x4*)(U + (size_t)(p0 - W + 1 + j) * 1024 + c0);
    float sum[8];
#pragma unroll
    for (int e = 0; e < 8; ++e) sum[e] = 0.f;
#pragma unroll
    for (int j = 0; j < W - 1; ++j) { sum[0] += bflo(v[j].x); sum[1] += bfhi(v[j].x); sum[2] += bflo(v[j].y); sum[3] += bfhi(v[j].y); sum[4] += bflo(v[j].z); sum[5] += bfhi(v[j].z); sum[6] += bflo(v[j].w); sum[7] += bfhi(v[j].w); }
    constexpr float iw = 1.f / (float)W;
#pragma unroll
    for (int i = 0; i < 8; ++i) { const u32x4 x_ = v[W - 1 + i];
        const float x0 = bflo(x_.x), x1 = bfhi(x_.x), x2 = bflo(x_.y), x3 = bfhi(x_.y), x4 = bflo(x_.z), x5 = bfhi(x_.z), x6 = bflo(x_.w), x7 = bfhi(x_.w);
        sum[0] += x0; sum[1] += x1; sum[2] += x2; sum[3] += x3; sum[4] += x4; sum[5] += x5; sum[6] += x6; sum[7] += x7;
        u32x4 o; o.x = cvtpk(sum[0] * iw - x0, sum[1] * iw - x1); o.y = cvtpk(sum[2] * iw - x2, sum[3] * iw - x3); o.z = cvtpk(sum[4] * iw - x4, sum[5] * iw - x5); o.w = cvtpk(sum[6] * iw - x6, sum[7] * iw - x7);
        *(u32x4*)(PL + (size_t)(p0 + i - NMETA) * 2048 + c0) = o;
        const u32x4 q = v[i];
        sum[0] -= bflo(q.x); sum[1] -= bfhi(q.x); sum[2] -= bflo(q.y); sum[3] -= bfhi(q.y); sum[4] -= bflo(q.z); sum[5] -= bfhi(q.z); sum[6] -= bflo(q.w); sum[7] -= bfhi(q.w); }
}
__device__ __forceinline__ void pool_phase(Frame& F) {
    const Ids I = phase_ids(F.wave);
    const bf16_t* U = (const bf16_t*)(F.ws + WS_U); bf16_t* PL = (bf16_t*)(F.ws + WS_PL);
    const int gt = (F.vcu * NWAVES + I.wave) * 64 + I.lane, NT = F.G * NTHR;
    for (int item = gt; item < 1024 * 128; item += NT) {
        const int cc = item & 127, strip = item >> 7, c0 = cc * 8, g = c0 >> 8, p0 = NMETA + strip * 8;
        if (g == 0) pool_strip<2>(U, PL, p0, c0); else if (g == 1) pool_strip<4>(U, PL, p0, c0); else if (g == 2) pool_strip<8>(U, PL, p0, c0); else pool_strip<16>(U, PL, p0, c0);
    }
}
__device__ __forceinline__ void meta_stage2(Frame& F) {
    const Ids I = phase_ids(F.wave);
    const int bx_ = (int)blockIdx.x; int item;
    if (F.G == 256) { if ((bx_ & 7) != ((bx_ >> 3) & 7)) return; item = (bx_ >> 3) * NWAVES + I.wave; } else { item = bx_ * NWAVES + I.wave; if (item >= 256) return; }
    unsigned char* ws = F.ws; const int lane = I.lane, c16 = lane & 15, q4 = lane >> 4;
    const float* CK = (const float*)(ws + WS_XNM + 65536) + (size_t)c16 * 512;
    float ss = 0.f;
    for (int k = 0; k < 128; k += 4) { const f32x4 v = *(const f32x4*)(CK + q4 * 128 + k); ss += (v[0] * v[0] + v[1] * v[1]) + (v[2] * v[2] + v[3] * v[3]); }
    ss += __shfl_xor(ss, 16); ss += __shfl_xor(ss, 32);
    const float rstd_own = rsqrtf(ss * (1.f / 512.f) + EPS);
    const bf16_t* Bp = (const bf16_t*)(ws + WS_WQKV2) + (size_t)(3072 + 16 * item + c16) * 2048 + 8 * q4;
    f32x4 acc = {0.f, 0.f, 0.f, 0.f};
#pragma unroll 4
    for (int ks = 0; ks < 16; ++ks) { const f32x4 a0 = *(const f32x4*)(CK + 32 * ks + 8 * q4), a1 = *(const f32x4*)(CK + 32 * ks + 8 * q4 + 4);
        u32x4 aw; aw.x = cvtpk(a0[0], a0[1]); aw.y = cvtpk(a0[2], a0[3]); aw.z = cvtpk(a1[0], a1[1]); aw.w = cvtpk(a1[2], a1[3]);
        const bf16x8 bv = *(const bf16x8*)(Bp + 32 * ks); acc = __builtin_amdgcn_mfma_f32_16x16x32_bf16(__builtin_bit_cast(bf16x8, aw), bv, acc, 0, 0, 0); }
    const int cc = 16 * item + c16, h = cc >> 8, d = cc & 255;
    bf16_t* Kb = (bf16_t*)(ws + WS_K); bf16_t* Vb = (bf16_t*)(ws + WS_V);
#pragma unroll
    for (int r = 0; r < 4; ++r) { const int row = 4 * q4 + r; const float rs = __shfl(rstd_own, row); const bf16_t y = f2bf(acc[r] * rs);
        if (d < 128) Kb[((size_t)h * KROWS + SEQ + row) * QKD + d] = y; else Vb[((size_t)h * KROWS + SEQ + row) * VD + d - 128] = y; }
}
constexpr float QSCALE = 0.07216878364870323f * 1.4426950408889634f;
struct SchedP2 { pg8::TileOrder T; const char* A; const char* B; const char* XN; const char* WKR; int nh, hfirst, hstep, only_heavy;
    __device__ __forceinline__ void init(int G, int b, const char* A_, const char* B_, const char* XN_, const char* WKR_) { A = A_; B = B_; XN = XN_; WKR = WKR_;
        if (G == 256) { const int heavy = ((b & 7) == ((b >> 3) & 7)); nh = heavy; hfirst = b >> 3; hstep = 32; only_heavy = heavy;
            const int nb = (b >> 3) + (((b & 7) > ((b >> 3) & 7)) ? 1 : 0); T.init(32, 28, G - 32, b - nb); }
        else { nh = b < 32 ? (31 - b) / G + 1 : 0; hfirst = b; hstep = G; only_heavy = 0; T.init(32, 28, G, b); } }
    __device__ __forceinline__ bool next(int i, pg8::GUnit& u) const {
        if (i < nh) { const int pm = hfirst + i * hstep; u.pm = pm; u.pn = 28; u.aux = 0; u.nt = 32; u.A = XN + (size_t)pm * 256 * 4096; u.B = WKR; return true; }
        if (only_heavy) return false;
        int pm, pn; if (!T.tile(i - nh, pm, pn)) return false; u.pm = pm; u.pn = pn; u.aux = (i - nh) & 3; u.nt = 8;
        u.A = A + (size_t)pm * 256 * 4096 + (pn >= 12 ? 1024 : 0); u.B = B + (size_t)pn * 256 * 4096; return true; } };
struct EpiP2 {
    bf16_t* Q; bf16_t* Kb; bf16_t* Vb; const f32x2* RT; const LAS float* rtab;
    int abl = 0;
    __device__ __forceinline__ int nstores(const pg8::GUnit& u) const { return (abl || u.pn == 28) ? 0 : 16; }
#ifdef MK_P2ABL
#define P2_ST(p_, v_) do { if (abl & 2) asm volatile("" :: "v"(v_)); else *(u32x4*)(p_) = (v_); } while (0)
#else
#ifdef MK_NTST
#define P2_ST(p_, v_) do { __builtin_nontemporal_store((v_), (u32x4*)(p_)); } while (0)
#else
#define P2_ST(p_, v_) do { *(u32x4*)(p_) = (v_); } while (0)
#endif
#endif
    __device__ __forceinline__ void operator()(const f32x4 (&acc)[2][2][4][2], const pg8::GUnit& u, int wr, int wc, int fr, int fq) const {
        if (abl & 1) { asm volatile("" :: "v"(acc[0][0][0][0]), "v"(acc[1][1][3][1])); return; }
        const int pn = u.pn, rl0 = wr * 64 + fr, row0 = u.pm * 256 + rl0;
        const LAS float* rt = rtab + u.aux * 256;
#define P2_ROT(w, v0, v1, cs0, cs1) do { w.x = cvtpk(v0[0] * cs0[0] - v0[1] * cs0[1], v0[0] * cs0[1] + v0[1] * cs0[0]); w.y = cvtpk(v0[2] * cs0[2] - v0[3] * cs0[3], v0[2] * cs0[3] + v0[3] * cs0[2]); \
            w.z = cvtpk(v1[0] * cs1[0] - v1[1] * cs1[1], v1[0] * cs1[1] + v1[1] * cs1[0]); w.w = cvtpk(v1[2] * cs1[2] - v1[3] * cs1[3], v1[2] * cs1[3] + v1[3] * cs1[2]); } while (0)
        if (pn == 28) {
            if (wc < 2) { const int colr = wc * 32 + 8 * fq, i0 = colr >> 1;
                f32x4 cs[2][4][2];
#pragma unroll
                for (int ai = 0; ai < 2; ++ai)
#pragma unroll
                    for (int m = 0; m < 4; ++m) { const int r = row0 + ai * 128 + m * 16; cs[ai][m][0] = *(const f32x4*)(RT + (size_t)(r + NMETA) * 32 + i0); cs[ai][m][1] = *(const f32x4*)(RT + (size_t)(r + NMETA) * 32 + i0 + 2); }
#pragma unroll
                for (int ai = 0; ai < 2; ++ai)
#pragma unroll
                    for (int m = 0; m < 4; ++m) { const int r = row0 + ai * 128 + m * 16; const f32x4 v0 = acc[ai][0][m][0], v1 = acc[ai][0][m][1];
                        u32x4 w; P2_ROT(w, v0, v1, cs[ai][m][0], cs[ai][m][1]);
#pragma unroll
                        for (int h = 0; h < NH; ++h) P2_ST(Kb + ((size_t)h * KROWS + r) * QKD + 128 + colr, w); } }
        } else if (pn < 12) {
            const int cu = pn * 256 + wc * 32, c0 = cu + 8 * fq, d0 = cu % 192, d1 = (cu + 128) % 192;
            const int bjr = __builtin_amdgcn_readfirstlane(d0 >= 128 ? 0 : (d1 >= 128 ? 1 : -1));
            if (bjr >= 0) {
                const int c = c0 + bjr * 128, h = c / 192, d = c - h * 192, i0 = (d - 128) >> 1;
                const int hu = __builtin_amdgcn_readfirstlane((cu + bjr * 128) / 192), rowu = u.pm * 256 + wr * 64;
                const char* qbu = (const char*)(Q + ((size_t)hu * SEQ + rowu) * QKD); const unsigned qlo = (unsigned)((fr * QKD + d) * 2);
                const char* rtu = (const char*)(RT + (size_t)(rowu + NMETA) * 32); const unsigned rlo = (unsigned)((fr * 32 + i0) * 8);
                (void)h;
                f32x4 csA[4][2], csB[4][2]; u32x4 wq[4];
#define P2_RLOAD(ai, cs_) do { _Pragma("unroll") for (int m = 0; m < 4; ++m) { const int ro = (ai) * 128 + m * 16; cs_[m][0] = *(const f32x4*)(rtu + (size_t)ro * 256 + rlo); cs_[m][1] = *(const f32x4*)(rtu + (size_t)ro * 256 + rlo + 16); } } while (0)
#define P2_RCALC(ai, cs_) do { _Pragma("unroll") for (int m = 0; m < 4; ++m) { const float sc = rt[rl0 + (ai) * 128 + m * 16] * QSCALE; \
                    const f32x4 a0 = bjr ? acc[ai][1][m][0] : acc[ai][0][m][0], a1 = bjr ? acc[ai][1][m][1] : acc[ai][0][m][1]; const f32x4 v0 = a0 * sc, v1 = a1 * sc; \
                    u32x4 w; P2_ROT(w, v0, v1, cs_[m][0], cs_[m][1]); wq[m] = w; } } while (0)
#define P2_RSTORE(ai) do { _Pragma("unroll") for (int m = 0; m < 4; ++m) P2_ST(qbu + (size_t)((ai) * 128 + m * 16) * (QKD * 2) + qlo, wq[m]); } while (0)
                P2_RLOAD(0, csA); P2_RCALC(0, csA); P2_RLOAD(1, csB); P2_RSTORE(0); P2_RCALC(1, csB); P2_RSTORE(1);
#undef P2_RLOAD
#undef P2_RCALC
#undef P2_RSTORE
            }
#pragma unroll
            for (int bj = 0; bj < 2; ++bj) if (bj != bjr) { const int c = c0 + bj * 128, h = c / 192, d = c - h * 192;
                bf16_t* qb = Q + (size_t)h * SEQ * QKD + d;
#pragma unroll
                for (int ai = 0; ai < 2; ++ai)
#pragma unroll
                    for (int m = 0; m < 4; ++m) { const int rl = rl0 + ai * 128 + m * 16; const float sc = rt[rl] * QSCALE; const f32x4 v0 = acc[ai][bj][m][0] * sc, v1 = acc[ai][bj][m][1] * sc;
                        u32x4 w; w.x = cvtpk(v0[0], v0[1]); w.y = cvtpk(v0[2], v0[3]); w.z = cvtpk(v1[0], v1[1]); w.w = cvtpk(v1[2], v1[3]);
                        P2_ST(qb + (size_t)(u.pm * 256 + rl) * QKD, w); } }
        } else { const int h = pn - 12, dc = wc * 32 + 8 * fq;
#pragma unroll
            for (int ai = 0; ai < 2; ++ai)
#pragma unroll
                for (int m = 0; m < 4; ++m) { const int rl = rl0 + ai * 128 + m * 16, r = u.pm * 256 + rl; const float sc = rt[rl];
#pragma unroll
                    for (int bj = 0; bj < 2; ++bj) { const f32x4 v0 = acc[ai][bj][m][0] * sc, v1 = acc[ai][bj][m][1] * sc;
                        u32x4 w; w.x = cvtpk(v0[0], v0[1]); w.y = cvtpk(v0[2], v0[3]); w.z = cvtpk(v1[0], v1[1]); w.w = cvtpk(v1[2], v1[3]);
                        if (bj == 0) P2_ST(Kb + ((size_t)h * KROWS + r) * QKD + dc, w); else P2_ST(Vb + ((size_t)h * KROWS + r) * VD + dc, w); } }
        }
#undef P2_ROT
#undef P2_ST
        (void)row0;
    }
};


constexpr size_t WS_T1 = WS_K;
constexpr size_t WS_MG = WS_Q;
constexpr size_t WS_H1 = WS_G;
constexpr size_t WS_H1B = WS_XN;
constexpr size_t WS_H1S = WS_O;
struct SchedP4 { pg8::TileOrder T; const char* A0; const char* B0; const char* A1; const char* B1;
    __device__ __forceinline__ bool next(int i, pg8::GUnit& u) const { int pm, pn; if (!T.tile(i >> 1, pm, pn)) return false; u.pm = pm; u.pn = pn; u.aux = i & 1; u.nt = (i & 1) ? 16 : 32;
        u.A = ((i & 1) ? A1 : A0) + (size_t)pm * 256 * 4096; u.B = ((i & 1) ? B1 : B0) + (size_t)pn * 256 * 4096; return true; } };
struct EpiP4 {
    const bf16_t* G; bf16_t* MG;
    static constexpr float GMIN = 1e-20f;
    __device__ __forceinline__ bool carry(const pg8::GUnit& u) const { return u.aux == 0; }
    __device__ __forceinline__ void rescale(f32x4 (&acc)[2][2][4][2], const pg8::GUnit& u, int wr, int wc, int fr, int fq) const {
        const int row0 = u.pm * 256 + wr * 64 + fr, col0 = u.pn * 256 + wc * 32 + 8 * fq;
        const bf16_t* gp = G + (size_t)row0 * 4096 + col0;
#pragma unroll
        for (int ai = 0; ai < 2; ++ai) { u32x4 g1[4][2], g2[4][2];
#pragma unroll
            for (int m = 0; m < 4; ++m)
#pragma unroll
                for (int bj = 0; bj < 2; ++bj) { const bf16_t* q = gp + (size_t)(ai * 128 + m * 16) * 4096 + bj * 128; g1[m][bj] = *(const u32x4*)q; g2[m][bj] = *(const u32x4*)(q + 2048); }
#pragma unroll
            for (int m = 0; m < 4; ++m)
#pragma unroll
                for (int bj = 0; bj < 2; ++bj) { const u32x4 a = g1[m][bj], b = g2[m][bj];
#define P4_R(x, y) ((x) * __builtin_amdgcn_rcpf(fmaxf((y), GMIN)))
                    const f32x4 r0 = {P4_R(bflo(a.x), bflo(b.x)), P4_R(bfhi(a.x), bfhi(b.x)), P4_R(bflo(a.y), bflo(b.y)), P4_R(bfhi(a.y), bfhi(b.y))};
                    const f32x4 r1 = {P4_R(bflo(a.z), bflo(b.z)), P4_R(bfhi(a.z), bfhi(b.z)), P4_R(bflo(a.w), bflo(b.w)), P4_R(bfhi(a.w), bfhi(b.w))};
#undef P4_R
                    acc[ai][bj][m][0] *= r0; acc[ai][bj][m][1] *= r1; } }
    }
    __device__ __forceinline__ void operator()(const f32x4 (&acc)[2][2][4][2], const pg8::GUnit& u, int wr, int wc, int fr, int fq) const {
        const int row0 = u.pm * 256 + wr * 64 + fr, col0 = u.pn * 256 + wc * 32 + 8 * fq;
        const bf16_t* gp = G + (size_t)row0 * 4096 + 2048 + col0; bf16_t* op = MG + (size_t)row0 * 2048 + col0;
        u32x4 g2[2][4][2];
#pragma unroll
        for (int ai = 0; ai < 2; ++ai)
#pragma unroll
            for (int m = 0; m < 4; ++m)
#pragma unroll
                for (int bj = 0; bj < 2; ++bj) g2[ai][m][bj] = *(const u32x4*)(gp + (size_t)(ai * 128 + m * 16) * 4096 + bj * 128);
#pragma unroll
        for (int ai = 0; ai < 2; ++ai)
#pragma unroll
            for (int m = 0; m < 4; ++m)
#pragma unroll
                for (int bj = 0; bj < 2; ++bj) { const u32x4 g = g2[ai][m][bj]; const f32x4 v0 = acc[ai][bj][m][0], v1 = acc[ai][bj][m][1];
                    u32x4 w; w.x = cvtpk(fmaxf(bflo(g.x), GMIN) * v0[0], fmaxf(bfhi(g.x), GMIN) * v0[1]); w.y = cvtpk(fmaxf(bflo(g.y), GMIN) * v0[2], fmaxf(bfhi(g.y), GMIN) * v0[3]);
                    w.z = cvtpk(fmaxf(bflo(g.z), GMIN) * v1[0], fmaxf(bfhi(g.z), GMIN) * v1[1]); w.w = cvtpk(fmaxf(bflo(g.w), GMIN) * v1[2], fmaxf(bfhi(g.w), GMIN) * v1[3]);
                    *(u32x4*)(op + (size_t)(ai * 128 + m * 16) * 2048 + bj * 128) = w; }
    }
};
struct SchedP5 { pg8::TileOrder T; const char* A; const char* B;
    __device__ __forceinline__ bool next(int i, pg8::GUnit& u) const { int pm, pn; if (!T.tile(i, pm, pn)) return false; u.pm = pm; u.pn = pn; u.aux = 0; u.nt = 32; u.A = A + (size_t)pm * 256 * 4096; u.B = B + (size_t)pn * 256 * 4096; return true; } };
struct EpiP5 {
    const float* X; float* H1; bf16_t* H1B; float* SS2; bf16_t* H1S; const float* WF;
    __device__ __forceinline__ void init(f32x4 (&acc)[2][2][4][2], const pg8::GUnit& u, int wr, int wc, int fr, int fq) const {
        const int row0 = u.pm * 256 + wr * 64 + fr, col0 = u.pn * 256 + wc * 32 + 8 * fq;
#pragma unroll
        for (int ai = 0; ai < 2; ++ai)
#pragma unroll
            for (int m = 0; m < 4; ++m)
#pragma unroll
                for (int bj = 0; bj < 2; ++bj) { const size_t off = (size_t)(row0 + ai * 128 + m * 16) * 2048 + col0 + bj * 128;
                    acc[ai][bj][m][0] = *(const f32x4*)(X + off); acc[ai][bj][m][1] = *(const f32x4*)(X + off + 4); }
    }
    __device__ __forceinline__ void operator()(const f32x4 (&acc)[2][2][4][2], const pg8::GUnit& u, int wr, int wc, int fr, int fq) const {
        const int row0 = u.pm * 256 + wr * 64 + fr, col0 = u.pn * 256 + wc * 32 + 8 * fq;
        f32x4 wf[2][2];
#pragma unroll
        for (int bj = 0; bj < 2; ++bj) { wf[bj][0] = *(const f32x4*)(WF + col0 + bj * 128); wf[bj][1] = *(const f32x4*)(WF + col0 + bj * 128 + 4); }
#pragma unroll
        for (int ai = 0; ai < 2; ++ai)
#pragma unroll
            for (int m = 0; m < 4; ++m) { const int r = row0 + ai * 128 + m * 16;
#pragma unroll
                for (int bj = 0; bj < 2; ++bj) { const int c = col0 + bj * 128; const size_t off = (size_t)r * 2048 + c;
                    const f32x4 t0 = acc[ai][bj][m][0], t1 = acc[ai][bj][m][1];
                    u32x4 w; w.x = cvtpk(t0[0], t0[1]); w.y = cvtpk(t0[2], t0[3]); w.z = cvtpk(t1[0], t1[1]); w.w = cvtpk(t1[2], t1[3]);
                    *(u32x4*)(H1B + off) = w;
                    { const f32x4 f0 = wf[bj][0], f1 = wf[bj][1]; u32x4 ws_; ws_.x = cvtpk(t0[0] * f0[0], t0[1] * f0[1]); ws_.y = cvtpk(t0[2] * f0[2], t0[3] * f0[3]); ws_.z = cvtpk(t1[0] * f1[0], t1[1] * f1[1]); ws_.w = cvtpk(t1[2] * f1[2], t1[3] * f1[3]);
                      *(u32x4*)(H1S + off) = ws_; }
                    float sq = (t0[0] * t0[0] + t0[1] * t0[1]) + (t0[2] * t0[2] + t0[3] * t0[3]) + (t1[0] * t1[0] + t1[1] * t1[1]) + (t1[2] * t1[2] + t1[3] * t1[3]);
                    sq += __shfl_xor(sq, 16); sq += __shfl_xor(sq, 32);
                    if (fq == 0) SS2[(size_t)r * 64 + u.pn * 8 + bj * 4 + wc] = sq; } }
    }
};


constexpr size_t RT_EID = WS_RT, RT_WGT = WS_RT + 65536, RT_RS2 = WS_RT + 131072, RT_CNTB = WS_RT + 196608, RT_OFF = WS_RT + 262144  ,
                 RT_STOK = WS_RT + 327680, RT_SW = WS_RT + 458752, RT_SRS = WS_RT + 589824, RT_SDST = WS_RT + 720896;
constexpr size_t WS_HDN = WS_CQKV;
constexpr size_t WS_Y = WS_K;
__device__ __forceinline__ void router_phase(Frame& F, const Args& a, const int abl = 0) {
    const Ids I = phase_ids(F.wave); const int tid = I.tid;
    unsigned char* ws = F.ws; const int lane = I.lane, c16 = lane & 15, q4 = lane >> 4, wave = I.wave;
    LAS float* red = (LAS float*)F.lds;
    LAS int* hist = (LAS int*)(F.lds + 8 * 32 * 80 * 4);
    for (int blk = blockIdx.x; blk < SEQ / 32; blk += F.G) {
        const int row0 = blk * 32;
        const bf16_t* Ap = (const bf16_t*)(ws + WS_H1S) + (size_t)(row0 + c16) * D + wave * 256 + 8 * q4;
        const bf16_t* Bp = (const bf16_t*)(ws + WS_WR) + (size_t)c16 * D + wave * 256 + 8 * q4;
        f32x4 acc[2][5];
#pragma unroll
        for (int r = 0; r < 2; ++r)
#pragma unroll
            for (int j = 0; j < 5; ++j) acc[r][j] = (f32x4){0.f, 0.f, 0.f, 0.f};
        if (!(abl & 1))
#pragma unroll 4
        for (int ks = 0; ks < 8; ++ks) { const bf16x8 av0 = *(const bf16x8*)(Ap + 32 * ks), av1 = *(const bf16x8*)(Ap + (size_t)16 * D + 32 * ks);
#pragma unroll
            for (int j = 0; j < 5; ++j) { const bf16x8 bv = *(const bf16x8*)(Bp + (size_t)j * 16 * D + 32 * ks);
                acc[0][j] = __builtin_amdgcn_mfma_f32_16x16x32_bf16(av0, bv, acc[0][j], 0, 0, 0); acc[1][j] = __builtin_amdgcn_mfma_f32_16x16x32_bf16(av1, bv, acc[1][j], 0, 0, 0); } }
        if (tid < 64) hist[tid] = 0;
#pragma unroll
        for (int rb = 0; rb < 2; ++rb)
#pragma unroll
            for (int j = 0; j < 5; ++j)
#pragma unroll
                for (int r = 0; r < 4; ++r) red[(wave * 32 + rb * 16 + 4 * q4 + r) * 80 + 16 * j + c16] = acc[rb][j][r];
        __syncthreads();
        if (tid < 32 && !(abl & 2)) { const int t = row0 + tid;
            const f32x4* sp = (const f32x4*)((const float*)(ws + WS_SS2) + (size_t)t * 64); float ssum = 0.f;
#pragma unroll
            for (int j = 0; j < 16; ++j) { const f32x4 v = sp[j]; ssum += (v[0] + v[1]) + (v[2] + v[3]); }
            const float rstd = rsqrtf(ssum * (1.f / D) + EPS);
            const LAS float* rp = red + tid * 80;
#define RSUM(c_) (((rp[c_] + rp[32 * 80 + (c_)]) + (rp[64 * 80 + (c_)] + rp[96 * 80 + (c_)])) + ((rp[128 * 80 + (c_)] + rp[160 * 80 + (c_)]) + (rp[192 * 80 + (c_)] + rp[224 * 80 + (c_)])))
            float g[8]; float gm = -1e30f; int gi = 0;
#pragma unroll
            for (int i = 0; i < 8; ++i) { g[i] = rstd * RSUM(i) + a.in[15][i]; if (g[i] > gm) { gm = g[i]; gi = i; } }
            float den = 0.f;
#pragma unroll
            for (int i = 0; i < 8; ++i) den += __expf(g[i] - gm);
            const float pg = 1.f / den;
            float e[8];
#pragma unroll
            for (int i = 0; i < 8; ++i) { const int c = 8 + gi * 8 + i; e[i] = rstd * RSUM(c) + a.in[17][gi * 8 + i]; }
#undef RSUM
            float v1 = -1e30f; int i1 = 0;
#pragma unroll
            for (int i = 0; i < 8; ++i) if (e[i] > v1) { v1 = e[i]; i1 = i; }
            float v2 = -1e30f; int i2 = 0;
#pragma unroll
            for (int i = 0; i < 8; ++i) if (i != i1 && e[i] > v2) { v2 = e[i]; i2 = i; }
            const float p2 = __expf(v2 - v1), sm = 1.f / (1.f + p2);
            int* eid = (int*)(ws + RT_EID); float* wgt = (float*)(ws + RT_WGT);
            eid[t * 2] = gi * 8 + i1; eid[t * 2 + 1] = gi * 8 + i2; wgt[t * 2] = pg * sm; wgt[t * 2 + 1] = pg * p2 * sm;
            ((float*)(ws + RT_RS2))[t] = rstd;
            atomicAdd((int*)&hist[gi * 8 + i1], 1); atomicAdd((int*)&hist[gi * 8 + i2], 1);
        }
        __syncthreads();
        if (tid < 64 && !(abl & 2)) ((int*)(ws + RT_CNTB))[blk * 64 + tid] = hist[tid];
        __syncthreads();
    }
}
__device__ __forceinline__ void slots_phase(Frame& F) {
    unsigned char* ws = F.ws; const int tid = opaque_tid(F.wave);
    LAS int* tot = (LAS int*)F.lds; LAS int* offs = tot + 64; LAS int* ent = tot + 192; LAS int* pt = tot + 256; LAS int* pb = pt + 512;
    const int* cntb = (const int*)(ws + RT_CNTB); const int* eid = (const int*)(ws + RT_EID);
    for (int blk = blockIdx.x; blk < SEQ / 32; blk += F.G) {
        { const int e = tid & 63, part = tid >> 6; int c[32];
#pragma unroll
          for (int i = 0; i < 32; ++i) c[i] = cntb[(32 * part + i) * 64 + e];
          int total = 0, before = 0;
#pragma unroll
          for (int i = 0; i < 32; ++i) { total += c[i]; if (32 * part + i < blk) before += c[i]; }
          pt[part * 64 + e] = total; pb[part * 64 + e] = before; }
        if (tid < 64) ent[tid] = eid[blk * 64 + tid];
        __syncthreads();
        int before = 0;
        if (tid < 64) { int total = 0;
#pragma unroll
            for (int p_ = 0; p_ < 8; ++p_) { total += pt[p_ * 64 + tid]; before += pb[p_ * 64 + tid]; }
            tot[tid] = total; }
        __syncthreads();
        if (tid == 0) { int acc = 0; for (int e = 0; e < 64; ++e) { offs[e] = acc; acc += tot[e]; } offs[64] = acc; }
        __syncthreads();
        if (tid < 64) { int pos = offs[tid] + before;
            int* stok = (int*)(ws + RT_STOK); float* sw = (float*)(ws + RT_SW); float* srs = (float*)(ws + RT_SRS); int* sdst = (int*)(ws + RT_SDST);
            const float* wgt = (const float*)(ws + RT_WGT); const float* rs2 = (const float*)(ws + RT_RS2);
            for (int i = 0; i < 64; ++i) if (ent[i] == tid) { const int tk = blk * 32 + (i >> 1); stok[pos] = tk; sw[pos] = wgt[blk * 64 + i]; srs[pos] = rs2[tk]; sdst[pos] = blk * 64 + i; ++pos; }
            if (blk == 0) { int* off = (int*)(ws + RT_OFF); off[tid] = offs[tid]; off[128 + tid] = tot[tid]; if (tid == 0) off[64] = offs[64]; } }
        __syncthreads();
    }
}
#ifndef MK_KOFF
#define MK_KOFF 0
#endif
struct MoeTiles {
    const LAS int* tpre; const LAS int* off; const LAS int* cnt;
    __device__ __forceinline__ bool find(int tl, int& e, int& ti) const { if (tl >= tpre[64]) return false; int lo = 0; for (int k = 32; k > 0; k >>= 1) if (tpre[lo + k] <= tl) lo += k; e = lo; ti = tl - tpre[lo]; return true; }
};
__device__ __forceinline__ MoeTiles moe_tiles_build(Frame& F) {
    const int tid = opaque_tid(F.wave);
    LAS int* tp = (LAS int*)(F.lds + MISC_OFF + 5120); LAS int* of = tp + 80; LAS int* cn = tp + 160;
    const int* off = (const int*)(F.ws + RT_OFF);
    if (tid < 64) { of[tid] = off[tid]; cn[tid] = off[128 + tid]; }
    __syncthreads();
    if (tid == 0) { int acc = 0; for (int e = 0; e < 64; ++e) { tp[e] = acc; acc += (cn[e] + 383) / 384; } tp[64] = acc; of[64] = off[64]; }
    __syncthreads();
    return MoeTiles{tp, of, cn};
}
struct SchedP8 { MoeTiles M; int G, c; const char* A; const char* B; const int* stok;
    __device__ __forceinline__ bool next(int i, pg8::GUnit& u) const { const int uu = i * G + c; int e, ti; if (!M.find(uu >> 2, e, ti)) return false; u.pm = M.off[e] + ti * 256; u.aux = M.off[e] + M.cnt[e]; u.pn = ((uu & 3) << 8) | e; u.nt = 32;
        u.A = A; u.B = B + ((size_t)e * 1024 + (uu & 3) * 256) * 4096; return true; }
    __device__ __forceinline__ unsigned arow(const pg8::GUnit& u, int r) const { const int sl = u.pm + r; const int tk = sl < u.aux ? stok[sl] : 0; return (unsigned)tk * 4096u; } };
struct EpiP8 {
    bf16_t* HDN; const float* srs;
    __device__ __forceinline__ void operator()(const f32x4 (&acc)[2][2][4][2], const pg8::GUnit& u, int wr, int wc, int fr, int fq) const {
        const int pn = u.pn >> 8, j0 = (pn * 256 + wc * 32 + 8 * fq) >> 1;
#pragma unroll
        for (int ai = 0; ai < 2; ++ai)
#pragma unroll
            for (int m = 0; m < 4; ++m) { const int sl = u.pm + ai * 128 + wr * 64 + m * 16 + fr;
                if (sl < u.aux) { const float rs = srs[sl];
#pragma unroll
                    for (int bj = 0; bj < 2; ++bj) { const f32x4 v0 = acc[ai][bj][m][0] * rs, v1 = acc[ai][bj][m][1] * rs;
                        const float h0 = v0[0] * sigmoidf_(v0[0]) * v0[1], h1 = v0[2] * sigmoidf_(v0[2]) * v0[3], h2 = v1[0] * sigmoidf_(v1[0]) * v1[1], h3 = v1[2] * sigmoidf_(v1[2]) * v1[3];
                        u32x2 w; w.x = cvtpk(h0, h1); w.y = cvtpk(h2, h3);
                        *(u32x2*)(HDN + (size_t)sl * 512 + j0 + bj * 64) = w; } } }
    }
};
struct SchedP9 { MoeTiles M; int G, c; const char* A; const char* B;
    __device__ __forceinline__ bool next(int i, pg8::GUnit& u) const { const int uu = i * G + c; int e, ti; if (!M.find(uu >> 3, e, ti)) return false; u.pm = M.off[e] + ti * 256; u.aux = M.off[e] + M.cnt[e]; u.pn = uu & 7; u.nt = 8;
        u.A = A + (size_t)u.pm * 1024; u.B = B + ((size_t)e * 2048 + (uu & 7) * 256) * 1024; return true; } };
struct EpiP9 {
    bf16_t* Y; const float* sw; const int* sdst;
    __device__ __forceinline__ void operator()(const f32x4 (&acc)[2][2][4][2], const pg8::GUnit& u, int wr, int wc, int fr, int fq) const {
        const int col0 = u.pn * 256 + wc * 32 + 8 * fq;
#pragma unroll
        for (int ai = 0; ai < 2; ++ai)
#pragma unroll
            for (int m = 0; m < 4; ++m) { const int sl = u.pm + ai * 128 + wr * 64 + m * 16 + fr;
                if (sl < u.aux) { const float w_ = sw[sl]; bf16_t* yp = Y + (size_t)sdst[sl] * 2048 + col0;
#pragma unroll
                    for (int bj = 0; bj < 2; ++bj) { const f32x4 v0 = acc[ai][bj][m][0] * w_, v1 = acc[ai][bj][m][1] * w_;
                        u32x4 w; w.x = cvtpk(v0[0], v0[1]); w.y = cvtpk(v0[2], v0[3]); w.z = cvtpk(v1[0], v1[1]); w.w = cvtpk(v1[2], v1[3]);
                        *(u32x4*)(yp + bj * 128) = w; } } }
    }
};

struct SchedM4Up { MoeTiles M; int G, c; const char* A; const float* Wg; const float* Wu; const int* stok;
    __device__ __forceinline__ bool next(int i, m4::MUnit& u) const { int tl, ns; if ((G & 63) == 0) { const int x = c & 7, j = c >> 3, tpx = G >> 6; tl = (i * 8 + x) * tpx + (j >> 3); ns = j & 7; } else { const int uu = i * G + c; tl = uu >> 3; ns = uu & 7; }
        int e, ti; if (!M.find(tl, e, ti)) return false; u.pm = M.off[e] + ti * 384; u.aux = M.off[e] + M.cnt[e]; u.ns = ns; u.nK = 64; u.koff = MK_KOFF ? (e * 8 + ns) * 13 : 0;
        u.A = A; u.B0 = Wg + (size_t)e * 2048 * 512 + 64 * ns; u.B1 = Wu + (size_t)e * 2048 * 512 + 64 * ns; return true; }
    __device__ __forceinline__ unsigned arow(const m4::MUnit& u, int r) const { const int sl = u.pm + r; const int tk = sl < u.aux ? stok[sl] : 0; return (unsigned)tk * 4096u; } };
struct EpiM4Up {
    bf16_t* HDN; const float* srs;
    __device__ __forceinline__ void operator()(const f32x4 (&acc)[3][8], const m4::MUnit& u, int wid, int fr, int fq) const {
        float rsv[3];
#pragma unroll
        for (int m = 0; m < 3; ++m) { const int sl = u.pm + 48 * wid + 16 * m + fr; rsv[m] = srs[min(sl, u.aux - 1)]; }
        asm volatile("" : "+v"(rsv[0]), "+v"(rsv[1]), "+v"(rsv[2]));
#pragma unroll
        for (int m = 0; m < 3; ++m) { const int sl = u.pm + 48 * wid + 16 * m + fr;
            if (sl < u.aux && 48 * wid + 16 * m + fr < m4::ROWS) { const float rs = rsv[m];
#pragma unroll
                for (int g = 0; g < 4; ++g) { const f32x4 v0 = acc[m][2 * g] * rs, v1 = acc[m][2 * g + 1] * rs;
                    const float h0 = v0[0] * sigmoidf_(v0[0]) * v0[1], h1 = v0[2] * sigmoidf_(v0[2]) * v0[3], h2 = v1[0] * sigmoidf_(v1[0]) * v1[1], h3 = v1[2] * sigmoidf_(v1[2]) * v1[3];
                    u32x2 w; w.x = cvtpk(h0, h1); w.y = cvtpk(h2, h3);
                    *(u32x2*)(HDN + (size_t)sl * 512 + 64 * u.ns + 16 * g + 4 * fq) = w; } } }
    }
};
struct SchedM4Down { MoeTiles M; int G, c; const char* A; const float* Wd;
    __device__ __forceinline__ bool next(int i, m4::MUnit& u) const { int tl, ns; if ((G & 127) == 0) { const int x = c & 7, j = c >> 3, tpx = G >> 7; tl = (i * 8 + x) * tpx + (j >> 4); ns = j & 15; } else { const int uu = i * G + c; tl = uu >> 4; ns = uu & 15; }
        int e, ti; if (!M.find(tl, e, ti)) return false; u.pm = M.off[e] + ti * 384; u.aux = M.off[e] + M.cnt[e]; u.ns = ns; u.nK = 16; u.koff = MK_KOFF ? (e * 16 + ns) * 5 : 0;
        u.A = A + (size_t)u.pm * 1024; u.B0 = Wd + (size_t)e * 512 * 2048 + 128 * ns; u.B1 = nullptr; return true; }
    __device__ __forceinline__ unsigned arow(const m4::MUnit&, int) const { return 0u; } };
struct EpiM4Down {
    bf16_t* Y; const float* sw; const int* sdst;
    __device__ __forceinline__ void operator()(const f32x4 (&acc)[3][8], const m4::MUnit& u, int wid, int fr, int fq) const {
        float swv[3]; int sdv[3];
#pragma unroll
        for (int m = 0; m < 3; ++m) { const int slc = min(u.pm + 48 * wid + 16 * m + fr, u.aux - 1); swv[m] = sw[slc]; sdv[m] = sdst[slc]; }
        asm volatile("" : "+v"(swv[0]), "+v"(swv[1]), "+v"(swv[2]), "+v"(sdv[0]), "+v"(sdv[1]), "+v"(sdv[2]));
#pragma unroll
        for (int m = 0; m < 3; ++m) { const int sl = u.pm + 48 * wid + 16 * m + fr;
            if (sl < u.aux) { const float w_ = swv[m]; bf16_t* yp = Y + (size_t)sdv[m] * 2048 + 128 * u.ns + 8 * fq;
#pragma unroll
                for (int g = 0; g < 4; ++g) { const f32x4 v0 = acc[m][2 * g] * w_, v1 = acc[m][2 * g + 1] * w_;
                    u32x4 w; w.x = cvtpk(v0[0], v0[1]); w.y = cvtpk(v0[2], v0[3]); w.z = cvtpk(v1[0], v1[1]); w.w = cvtpk(v1[2], v1[3]);
                    *(u32x4*)(yp + 32 * g) = w; } } }
    }
};
__device__ __forceinline__ void final_phase(Frame& F, const Args& a) {
    const Ids I = phase_ids(F.wave);
    unsigned char* ws = F.ws; const int gw = F.vcu * NWAVES + I.wave, NGW = F.G * NWAVES, lane = I.lane;
    const f32x4* fwp = (const f32x4*)a.in[21] + lane;
    f32x4 fw[8];
#pragma unroll
    for (int j = 0; j < 8; ++j) fw[j] = fwp[64 * j];
    u32x2 h0[8], h1[8], p0[8], p1[8], q0[8], q1[8];
#define FIN_LOAD(t0_, t1c_) do { const u32x2* hp0 = (const u32x2*)((const bf16_t*)(ws + WS_H1B) + (size_t)(t0_) * D) + lane; const u32x2* hp1 = (const u32x2*)((const bf16_t*)(ws + WS_H1B) + (size_t)(t1c_) * D) + lane; \
        const u32x2* ya0 = (const u32x2*)((const bf16_t*)(ws + WS_Y) + (size_t)(2 * (t0_)) * D) + lane; const u32x2* ya1 = (const u32x2*)((const bf16_t*)(ws + WS_Y) + (size_t)(2 * (t1c_)) * D) + lane; \
        _Pragma("unroll") for (int j = 0; j < 8; ++j) { h0[j] = hp0[64 * j]; p0[j] = ya0[64 * j]; q0[j] = ya0[D / 4 + 64 * j]; h1[j] = hp1[64 * j]; p1[j] = ya1[64 * j]; q1[j] = ya1[D / 4 + 64 * j]; } } while (0)
    int t0 = gw;
    if (t0 < SEQ) { const int t1 = t0 + NGW; FIN_LOAD(t0, t1 < SEQ ? t1 : t0); }
    for (; t0 < SEQ; t0 += 2 * NGW) {
        const int t1 = t0 + NGW; const bool has1 = t1 < SEQ; const int t1c = has1 ? t1 : t0;
        f32x4 v0[8], v1[8]; float s0 = 0.f, s1 = 0.f;
#pragma unroll
        for (int j = 0; j < 8; ++j) {
            v0[j] = (f32x4){bflo(h0[j].x) + bflo(p0[j].x) + bflo(q0[j].x), bfhi(h0[j].x) + bfhi(p0[j].x) + bfhi(q0[j].x), bflo(h0[j].y) + bflo(p0[j].y) + bflo(q0[j].y), bfhi(h0[j].y) + bfhi(p0[j].y) + bfhi(q0[j].y)};
            v1[j] = (f32x4){bflo(h1[j].x) + bflo(p1[j].x) + bflo(q1[j].x), bfhi(h1[j].x) + bfhi(p1[j].x) + bfhi(q1[j].x), bflo(h1[j].y) + bflo(p1[j].y) + bflo(q1[j].y), bfhi(h1[j].y) + bfhi(p1[j].y) + bfhi(q1[j].y)};
            s0 += (v0[j][0] * v0[j][0] + v0[j][1] * v0[j][1]) + (v0[j][2] * v0[j][2] + v0[j][3] * v0[j][3]);
            s1 += (v1[j][0] * v1[j][0] + v1[j][1] * v1[j][1]) + (v1[j][2] * v1[j][2] + v1[j][3] * v1[j][3]); }
        const int n0 = t0 + 2 * NGW;
        if (n0 < SEQ) { const int n1 = n0 + NGW; FIN_LOAD(n0, n1 < SEQ ? n1 : n0); }
        const float r0 = rsqrtf(wave_sum(s0) * (1.f / D) + EPS), r1 = rsqrtf(wave_sum(s1) * (1.f / D) + EPS);
        f32x4* o0 = (f32x4*)(a.out + (size_t)t0 * D) + lane; f32x4* o1 = (f32x4*)(a.out + (size_t)t1c * D) + lane;
#pragma unroll
        for (int j = 0; j < 8; ++j) { o0[64 * j] = v0[j] * r0 * fw[j]; if (has1) o1[64 * j] = v1[j] * r1 * fw[j]; }
    }
#undef FIN_LOAD
}
template <int DEPTH> __device__ __forceinline__ void stream_probe(Frame& F, const char* base, size_t bytes) {
    const Ids I = phase_ids(F.wave); const int gw = F.vcu * NWAVES + I.wave, NGW = F.G * NWAVES;
    const size_t per = (bytes / NGW) & ~(size_t)1023; const char* p0 = base + (size_t)gw * per; const int np = (int)(per >> 10);
    const unsigned ldsb = (unsigned)(size_t)F.lds + (unsigned)I.wave * 16384u; const unsigned voff = (unsigned)I.lane * 16u;
    for (int i = 0; i < np; ++i) { const char* b_ = p0 + (size_t)i * 1024; unsigned keep_; const unsigned d_ = (unsigned)__builtin_amdgcn_readfirstlane((int)(ldsb + (i & 15) * 1024));
        asm volatile("s_mov_b32 %0, m0\n\ts_mov_b32 m0, %2\n\ts_nop 0\n\tglobal_load_lds_dwordx4 %1, %3 nt\n\ts_mov_b32 m0, %0" : "=&s"(keep_) : "v"(voff), "s"(d_), "s"(b_) : "memory");
        if (DEPTH == 8) asm volatile("s_waitcnt vmcnt(7)" ::: "memory"); else asm volatile("s_waitcnt vmcnt(15)" ::: "memory"); }
    asm volatile("s_waitcnt vmcnt(0)" ::: "memory");
    __syncthreads();
}


template <int DEPTH> __device__ __forceinline__ void stream_probe_sliced(Frame& F, const char* base, size_t bytes) {
    const Ids I = phase_ids(F.wave); const int gw = F.vcu * NWAVES + I.wave, NGW = F.G * NWAVES;
#ifdef MK_PROBE3
    const int bx = blockIdx.x, slice = (bx >> 3) & 7, grpw = ((bx & 7) + 8 * (bx >> 6)) * NWAVES + I.wave, ngrp = NGW >> 3;
#else
    const int grpw = gw >> 3, slice = gw & 7, ngrp = NGW >> 3;
#endif
    const size_t rows_total = bytes >> 11; const size_t rows_per = (rows_total / ngrp) & ~(size_t)3; const char* p0 = base + (size_t)grpw * rows_per * 2048 + slice * 256;
    const int np = (int)(rows_per >> 2);
    const unsigned ldsb = (unsigned)(size_t)F.lds + (unsigned)I.wave * 16384u; const unsigned voff = (unsigned)((I.lane >> 4) * 2048 + (I.lane & 15) * 16);
    for (int i = 0; i < np; ++i) { const char* b_ = p0 + (size_t)i * 8192; unsigned keep_; const unsigned d_ = (unsigned)__builtin_amdgcn_readfirstlane((int)(ldsb + (i & 15) * 1024));
        asm volatile("s_mov_b32 %0, m0\n\ts_mov_b32 m0, %2\n\ts_nop 0\n\tglobal_load_lds_dwordx4 %1, %3 nt\n\ts_mov_b32 m0, %0" : "=&s"(keep_) : "v"(voff), "s"(d_), "s"(b_) : "memory");
        if (DEPTH == 8) asm volatile("s_waitcnt vmcnt(7)" ::: "memory"); else asm volatile("s_waitcnt vmcnt(15)" ::: "memory"); }
    asm volatile("s_waitcnt vmcnt(0)" ::: "memory");
    __syncthreads();
}

__global__ void __launch_bounds__(NTHR, 2) mega_fwd(Args args) {
    extern __shared__ __attribute__((aligned(16))) unsigned char lds_raw[];
    Frame F;
    F.lds = (LAS unsigned char*)lds_raw; F.MISC = (volatile LAS unsigned*)(F.lds + MISC_OFF);
    F.G = gridDim.x; { const int bx = blockIdx.x; F.vcu = (F.G % 8 == 0) ? (bx % 8) * (F.G / 8) + bx / 8 : bx; }
    F.ws = args.ws;
    unsigned char* ws = args.ws;
    F.wave = __builtin_amdgcn_readfirstlane((int)(threadIdx.x >> 6));
    for (int u = opaque_tid(F.wave); u < (LDS_BYTES - MISC_OFF) / 4; u += NTHR) ((LAS unsigned*)(F.lds + MISC_OFF))[u] = 0u;
    __syncthreads();
    XcdBarrier bar = xcd_barrier_post((unsigned*)(ws + WS_CTL) + CW_BAR, F.MISC + 8);
    if (args.never) cg::this_grid().sync();
    const int lo = args.ph_lo, hi = args.ph_hi;
#define IN(k) (lo <= (k) && (k) < hi)
#define SEAM(k) do { if (IN(k) && IN((k) + 1)) xcd_barrier(bar); } while (0)
#ifndef MK_EARLY
#define MK_EARLY true
#endif
#ifndef MK_REPEAT
#define MK_REPEAT -1
#endif
#define REPS(k) for (int rep_ = 0; rep_ < ((k) == MK_REPEAT ? 2 : 1); ++rep_, ((k) == MK_REPEAT && rep_ == 1) ? xcd_barrier(bar) : (void)0)
    if (IN(0)) REPS(0) { p0_prologue(F, args); }
    SEAM(0);
    if (IN(1)) REPS(1) {
        meta_stage1(F);
        weff_stage(F);
        SchedP1 S; S.T.init(32, 24, F.G, (int)blockIdx.x); S.A = (const char*)(ws + WS_XN); S.B = (const char*)(ws + WS_WIN);
        EpiP1 E{(bf16_t*)(ws + WS_CQKV2), (float*)(ws + WS_SSQ), (bf16_t*)(ws + WS_U), (bf16_t*)(ws + WS_G), (bf16_t*)(ws + WS_K), (const f32x2*)(ws + WS_ROPE)};
        pg8::gemm_phase<EpiP1, SchedP1>(F.wave, F.lds, 4096, 4096, S, E);
    }
    SEAM(1);
    if (IN(2)) REPS(2) {
        pool_phase(F);
#ifdef MK_POOLREP
        for (int pr_ = 0; pr_ < MK_POOLREP; ++pr_) { __syncthreads(); pool_phase(F); }
#endif
        meta_stage2(F);
        SchedP2 S; S.init(F.G, (int)blockIdx.x, (const char*)(ws + WS_CQKV2), (const char*)(ws + WS_WQKV2), (const char*)(ws + WS_XN), (const char*)(ws + WS_WIN) + (size_t)6144 * 4096);
        LAS float* rtab = (LAS float*)(F.lds + MISC_OFF + 1024);
        { const float* SSQ = (const float*)(ws + WS_SSQ); pg8::GUnit u; const int tid_ = opaque_tid(F.wave);
          for (int i = 0; i < 5; ++i) if (S.next(i, u) && u.pn != 28 && tid_ < 256) { const f32x4* sp = (const f32x4*)(SSQ + ((size_t)(u.pn >= 12 ? 1 : 0) * SEQ + u.pm * 256 + tid_) * 16);
              const f32x4 a0 = sp[0], a1 = sp[1], a2 = sp[2], a3 = sp[3]; const float ssum = ((a0[0] + a0[1]) + (a0[2] + a0[3])) + ((a1[0] + a1[1]) + (a1[2] + a1[3])) + ((a2[0] + a2[1]) + (a2[2] + a2[3])) + ((a3[0] + a3[1]) + (a3[2] + a3[3]));
              rtab[u.aux * 256 + tid_] = rsqrtf(ssum * (1.f / 512.f) + EPS); } }
        __syncthreads();
        EpiP2 E{(bf16_t*)(ws + WS_Q), (bf16_t*)(ws + WS_K), (bf16_t*)(ws + WS_V), (const f32x2*)(ws + WS_ROPE), rtab};
#ifdef MK_P2ABL
        E.abl = (rep_ == 1) ? MK_P2ABL : 0;
#endif
        pg8::gemm_phase<EpiP2, SchedP2, false, false, false, MK_EARLY>(F.wave, F.lds, 4096, 4096, S, E);
    }
    SEAM(2);
    if (IN(3)) {
        for (int pu_ = F.vcu; pu_ < (MK_REPEAT == 3 ? 512 : 256); pu_ += F.G) { const int pu = pu_ & 255, h = pu >> 4, sq = pu & 15;
            at::attn_unit(F.wave, h, 31 - sq, ws, (unsigned)WS_Q, (unsigned)WS_K, (unsigned)WS_V, (unsigned)WS_O, F.lds);
            at::attn_unit(F.wave, h, sq, ws, (unsigned)WS_Q, (unsigned)WS_K, (unsigned)WS_V, (unsigned)WS_O, F.lds); }
    }
    SEAM(3);
    if (IN(4)) REPS(4) {
        SchedP4 S; S.T.init(32, 8, F.G, (int)blockIdx.x); S.A0 = (const char*)(ws + WS_O); S.B0 = (const char*)(ws + WS_WO); S.A1 = (const char*)(ws + WS_PL); S.B1 = (const char*)(ws + WS_WPE);
        EpiP4 E{(const bf16_t*)(ws + WS_G), (bf16_t*)(ws + WS_MG)};
        pg8::gemm_phase<EpiP4, SchedP4, false, false, true>(F.wave, F.lds, 4096, 4096, S, E);
    }
    SEAM(4);
    if (IN(5)) REPS(5) {
        SchedP5 S; S.T.init(32, 8, F.G, (int)blockIdx.x); S.A = (const char*)(ws + WS_MG); S.B = (const char*)(ws + WS_WOUT);
        EpiP5 E{args.in[0], (float*)(ws + WS_H1), (bf16_t*)(ws + WS_H1B), (float*)(ws + WS_SS2), (bf16_t*)(ws + WS_H1S), args.in[13]};
        pg8::gemm_phase<EpiP5, SchedP5, false, true>(F.wave, F.lds, 4096, 4096, S, E);
    }
    SEAM(5);
#ifdef MK_BARPROBE
    if (IN(6)) { for (int i_ = 0; i_ < MK_BARPROBE; ++i_) xcd_barrier(bar); }
#endif
#ifdef MK_P6ABL
    if (IN(6)) REPS(6) router_phase(F, args, rep_ == 1 ? MK_P6ABL : 0);
#else
    if (IN(6)) REPS(6) router_phase(F, args);
#endif
    SEAM(6);
    if (IN(7)) REPS(7) slots_phase(F);
    SEAM(7);
#ifdef MK_STREAMPROBE2
    if (IN(8)) { stream_probe_sliced<MK_STREAMPROBE2>(F, (const char*)args.in[18], (size_t)64 * 2048 * 512 * 4); stream_probe_sliced<MK_STREAMPROBE2>(F, (const char*)args.in[19], (size_t)64 * 2048 * 512 * 4); stream_probe_sliced<MK_STREAMPROBE2>(F, (const char*)args.in[20], (size_t)64 * 2048 * 512 * 4); xcd_barrier(bar); }
#endif
#ifdef MK_STREAMPROBE
    if (IN(8)) { stream_probe<MK_STREAMPROBE>(F, (const char*)args.in[18], (size_t)64 * 2048 * 512 * 4); stream_probe<MK_STREAMPROBE>(F, (const char*)args.in[19], (size_t)64 * 2048 * 512 * 4); stream_probe<MK_STREAMPROBE>(F, (const char*)args.in[20], (size_t)64 * 2048 * 512 * 4); xcd_barrier(bar); }
#endif
    if (IN(8)) REPS(8) {
        const MoeTiles M = moe_tiles_build(F);
        SchedM4Up S{M, F.G, (int)blockIdx.x, (const char*)(ws + WS_H1S), args.in[18], args.in[19], (const int*)(ws + RT_STOK)};
        EpiM4Up E{(bf16_t*)(ws + WS_HDN), (const float*)(ws + RT_SRS)};
        m4::moe_phase<0, SchedM4Up, EpiM4Up>(F.wave, F.lds, S, E, args.in[13]);
#ifdef MK_ABL8
        xcd_barrier(bar);
        m4::moe_phase<0, SchedM4Up, EpiM4Up, MK_ABL8>(F.wave, F.lds, S, E, args.in[13]);
#endif
    }
    SEAM(8);
    if (IN(9)) REPS(9) {
        const MoeTiles M = moe_tiles_build(F);
        SchedM4Down S{M, F.G, (int)blockIdx.x, (const char*)(ws + WS_HDN), args.in[20]};
        EpiM4Down E{(bf16_t*)(ws + WS_Y), (const float*)(ws + RT_SW), (const int*)(ws + RT_SDST)};
        m4::moe_phase<1, SchedM4Down, EpiM4Down>(F.wave, F.lds, S, E, nullptr);
#ifdef MK_ABL9
        xcd_barrier(bar);
        m4::moe_phase<1, SchedM4Down, EpiM4Down, MK_ABL9>(F.wave, F.lds, S, E, nullptr);
#endif
    }
    SEAM(9);
    if (IN(10)) REPS(10) final_phase(F, args);
#undef IN
#undef SEAM
}

constexpr int N_PHASES = 11;
static int g_grid = 0;
inline bool mk_setup() {
    if (g_grid != 0) return g_grid > 0;
    int dev = 0, cus = 0, per_cu = 0;
    if (hipGetDevice(&dev) != hipSuccess || hipDeviceGetAttribute(&cus, hipDeviceAttributeMultiprocessorCount, dev) != hipSuccess) { g_grid = -1; return false; }
    if (hipFuncSetAttribute((const void*)mega_fwd, hipFuncAttributeMaxDynamicSharedMemorySize, LDS_BYTES) != hipSuccess) { fprintf(stderr, "mk: hipFuncSetAttribute failed\n"); g_grid = -1; return false; }
    if (hipOccupancyMaxActiveBlocksPerMultiprocessor(&per_cu, (const void*)mega_fwd, NTHR, LDS_BYTES) != hipSuccess || per_cu < 1) { fprintf(stderr, "mk: occupancy query says %d\n", per_cu); (void)hipGetLastError(); g_grid = -1; return false; }
    g_grid = cus;
    return true;
}
inline void mk_launch(void* const* d_in, float* d_out, unsigned char* ws, int ph_lo, int ph_hi, hipStream_t stream) {
    if (!mk_setup()) return;
    Args a{};
    for (int i = 0; i < 22; ++i) a.in[i] = (const float*)d_in[i];
    a.out = d_out; a.ws = ws; a.ph_lo = ph_lo; a.ph_hi = ph_hi; a.never = 0; a.pad = 0;
    void* kargs[] = {&a};
    hipError_t e = hipLaunchCooperativeKernel((const void*)mega_fwd, dim3(g_grid), dim3(NTHR), kargs, LDS_BYTES, stream);
    if (e != hipSuccess) fprintf(stderr, "mk: cooperative launch failed: %s (grid %d)\n", hipGetErrorString(e), g_grid);
}
}
extern "C" void kernel_launch(void* const* d_in, const int* in_sizes, int n_in, void* d_out, int out_size, void* d_ws, size_t ws_size, hipStream_t stream) {
    (void)in_sizes; (void)n_in; (void)ws_size; (void)out_size;
    unsigned char* ws = (unsigned char*)d_ws;
    (void)hipMemsetAsync(ws + mk::WS_CTL, 0, mk::CTL_ZERO_BYTES, stream);
#ifdef MK_SPLIT
    for (int p = 0; p < mk::N_PHASES; ++p) mk::mk_launch(d_in, (float*)d_out, ws, p, p + 1, stream);
#else
    mk::mk_launch(d_in, (float*)d_out, ws, 0, mk::N_PHASES, stream);
#endif
}
```

```cpp
#include <hip/hip_runtime.h>
#include <hip/hip_cooperative_groups.h>
#include <cstdint>
#include <cstddef>
#include <cstdio>
namespace mk {
namespace cg = cooperative_groups;
#define LAS __attribute__((address_space(3)))
#define GAS __attribute__((address_space(1)))
typedef unsigned short bf16_t;
typedef short bf16x8 __attribute__((ext_vector_type(8)));
typedef short s16x4 __attribute__((ext_vector_type(4)));
typedef float f32x4 __attribute__((ext_vector_type(4)));
typedef float f32x2 __attribute__((ext_vector_type(2)));
typedef float f32x16 __attribute__((ext_vector_type(16)));
typedef unsigned u32x4 __attribute__((ext_vector_type(4)));
typedef unsigned u32x2 __attribute__((ext_vector_type(2)));
typedef __bf16 bf16x2_t __attribute__((ext_vector_type(2)));

constexpr int D = 2048, SEQ = 8192, NMETA = 16, LTOT = SEQ + NMETA;
constexpr int NH = 16, QKD = 192, VD = 128;
constexpr int KROWS = SEQ + 64;
constexpr int NE = 64, FF = 512;
constexpr float EPS = 1e-6f;
constexpr int NWAVES = 8, NTHR = 512;

__device__ __forceinline__ unsigned cvtpk(float lo, float hi) { f32x2 v = {lo, hi}; bf16x2_t b = __builtin_convertvector(v, bf16x2_t); return __builtin_bit_cast(unsigned, b); }
__device__ __forceinline__ float bf2f(unsigned short b) { return __uint_as_float((unsigned)b << 16); }
__device__ __forceinline__ float bflo(unsigned w) { return __uint_as_float(w << 16); }
__device__ __forceinline__ float bfhi(unsigned w) { return __uint_as_float(w & 0xffff0000u); }
__device__ __forceinline__ unsigned short f2bf(float f) { return (unsigned short)(cvtpk(f, 0.f) & 0xffffu); }
__device__ __forceinline__ float wave_sum(float v) {
#pragma unroll
    for (int o = 1; o < 64; o <<= 1) v += __shfl_xor(v, o);
    return v;
}
__device__ __forceinline__ int lane_id() { unsigned m = ~0u; asm volatile("" : "+s"(m)); return (int)__builtin_amdgcn_mbcnt_hi(m, __builtin_amdgcn_mbcnt_lo(m, 0u)); }
__device__ __forceinline__ int opaque_tid(int wave) { return wave * 64 + lane_id(); }
__device__ __forceinline__ float sigmoidf_(float x) { return __builtin_amdgcn_rcpf(1.f + __builtin_amdgcn_exp2f(-1.4426950408889634f * x)); }

#define XB_TMO      128
#define XB_XCNT(j)  (256  + 64 * (j))
#define XB_XSUB(j)  (1280 + 64 * (j))
#define XB_XGEN(j)  (2304 + 64 * (j))
#define XB_TOP      3328
#define XB_TOPGEN   3392
#define XCD_BAR_WORDS 3456
#define XB_SPIN_CAP (1u << 20)
__device__ __forceinline__ unsigned xb_ld(unsigned* p)              { return __hip_atomic_load(p, __ATOMIC_RELAXED, __HIP_MEMORY_SCOPE_AGENT); }
__device__ __forceinline__ unsigned xb_add(unsigned* p, unsigned v) { return __hip_atomic_fetch_add(p, v, __ATOMIC_RELAXED, __HIP_MEMORY_SCOPE_AGENT); }
__device__ __forceinline__ unsigned xb_xcc_id() { return (unsigned)__builtin_amdgcn_s_getreg((3 << 11) | 20) & 0xFu; }
#define XB_SPIN(cond, bar) do { unsigned _sp = 0; while (cond) { __builtin_amdgcn_s_sleep(1); \
    if ((++_sp & 255u) == 0u) { if (xb_ld(&(bar)[XB_TMO])) break; if (_sp > XB_SPIN_CAP) { atomicAdd(&(bar)[XB_TMO], 1u); break; } } } } while (0)
struct XcdBarrier { unsigned* bar; unsigned x; volatile LAS unsigned* st; };
__device__ __forceinline__ XcdBarrier xcd_barrier_post(unsigned* bar, volatile LAS unsigned* st) {
    XcdBarrier b; b.bar = bar; b.x = xb_xcc_id(); b.st = st;
    if (threadIdx.x == 0) (void)xb_add(&bar[XB_XCNT(b.x)], 1u);
    return b;
}
__device__ __forceinline__ void xcd_barrier_complete(unsigned* bar, unsigned x, unsigned& nloc, unsigned& nx) {
    const unsigned G = gridDim.x * gridDim.y * gridDim.z;
    unsigned sum, cnt, mine, sp = 0u;
    for (;;) {
        sum = 0u; cnt = 0u; mine = 0u;
#pragma unroll
        for (unsigned j = 0; j < 16; ++j) { const unsigned c = xb_ld(&bar[XB_XCNT(j)]); sum += c; cnt += (c > 0u) ? 1u : 0u; mine = (j == x) ? c : mine; }
        if (sum == G) break;
        __builtin_amdgcn_s_sleep(1);
        if ((++sp & 255u) == 0u) { if (xb_ld(&bar[XB_TMO])) break; if (sp > XB_SPIN_CAP) { atomicAdd(&bar[XB_TMO], 1u); break; } }
    }
    nloc = mine > 0u ? mine : 1u; nx = cnt > 0u ? cnt : 1u;
}
__device__ __forceinline__ void xcd_barrier(const XcdBarrier& b) {
    asm volatile("s_waitcnt vmcnt(0)" ::: "memory");
    __syncthreads();
    if (threadIdx.x == 0) {
        unsigned* bar = b.bar;
        __builtin_amdgcn_s_waitcnt(0);
        unsigned nloc = b.st[0], nx = b.st[1];
        if (nloc == 0u) { xcd_barrier_complete(bar, b.x, nloc, nx); b.st[0] = nloc; b.st[1] = nx; }
        const unsigned old = xb_add(&bar[XB_XSUB(b.x)], 1u);
        const unsigned gen = old / nloc;
        if (old + 1u == (gen + 1u) * nloc) {
            __builtin_amdgcn_fence(__ATOMIC_RELEASE, "agent");
            asm volatile("s_waitcnt vmcnt(0)" ::: "memory");
            const unsigned og = xb_add(&bar[XB_TOP], 1u);
            const unsigned tg = og / nx;
            if (og + 1u == (tg + 1u) * nx) xb_add(&bar[XB_TOPGEN], 1u);
            else XB_SPIN(xb_ld(&bar[XB_TOPGEN]) == tg, bar);
            __builtin_amdgcn_fence(__ATOMIC_ACQUIRE, "agent");
            xb_add(&bar[XB_XGEN(b.x)], 1u);
            asm volatile("s_waitcnt vmcnt(0)" ::: "memory");
        } else {
            XB_SPIN(xb_ld(&bar[XB_XGEN(b.x)]) == gen, bar);
            __builtin_amdgcn_fence(__ATOMIC_ACQUIRE, "agent");
            asm volatile("s_waitcnt vmcnt(0)" ::: "memory");
        }
    }
    __syncthreads();
}

__device__ __forceinline__ void xcd_arrive(const XcdBarrier& b) {
    asm volatile("s_waitcnt vmcnt(0)" ::: "memory");
    __syncthreads();
    if (threadIdx.x == 0) {
        unsigned* bar = b.bar;
        __builtin_amdgcn_s_waitcnt(0);
        unsigned nloc = b.st[0], nx = b.st[1];
        if (nloc == 0u) { xcd_barrier_complete(bar, b.x, nloc, nx); b.st[0] = nloc; b.st[1] = nx; }
        const unsigned old = xb_add(&bar[XB_XSUB(b.x)], 1u);
        const unsigned gen = old / nloc;
        b.st[2] = gen;
        if (old + 1u == (gen + 1u) * nloc) {
            __builtin_amdgcn_fence(__ATOMIC_RELEASE, "agent");
            asm volatile("s_waitcnt vmcnt(0)" ::: "memory");
#ifdef MK_KEEP_GEN
            const unsigned og = xb_add(&bar[XB_TOP], 1u);
            const unsigned tg = og / nx;
            if (og + 1u == (tg + 1u) * nx) xb_add(&bar[XB_TOPGEN], 1u);
            xb_add(&bar[XB_XGEN(b.x)], 1u);
            asm volatile("s_waitcnt vmcnt(0)" ::: "memory");
#else
            (void)nx; __hip_atomic_fetch_add(&bar[XB_TOP], 1u, __ATOMIC_RELAXED, __HIP_MEMORY_SCOPE_AGENT);
#endif
        }
    }
    __syncthreads();
}
__device__ __forceinline__ void xcd_wait(const XcdBarrier& b) {
    asm volatile("s_waitcnt vmcnt(0)" ::: "memory");
    __syncthreads();
    if (threadIdx.x == 0) {
        unsigned* bar = b.bar;
        const unsigned want = (b.st[2] + 1u) * b.st[1];
        XB_SPIN((int)(xb_ld(&bar[XB_TOP]) - want) < 0, bar);
        __builtin_amdgcn_fence(__ATOMIC_ACQUIRE, "agent");
        asm volatile("s_waitcnt vmcnt(0)" ::: "memory");
    }
    __syncthreads();
}

namespace pg8 {
constexpr int BM = 256, BK = 64, HALF = 128, HTB = HALF * BK * 2, STAGE_BYTES = 8 * HTB;
__host__ __device__ __forceinline__ int lds_byte(int r, int c) { const int st = (r >> 4) * 2 + (c >> 5), rr = r & 15, cc = c & 31, ob = rr * 64 + cc * 2; return st * 1024 + (ob ^ (((ob >> 9) & 1) << 5)); }
__host__ __device__ __forceinline__ void stage_rc(int b, int& R, int& C) { const int st = b / 1024, sb = b % 1024, swz = sb ^ (((sb >> 9) & 1) << 5); R = (st >> 1) * 16 + swz / 64; C = (st & 1) * 32 + (swz % 64) / 2; }
__host__ __device__ __forceinline__ int perm32(int rho) { const int n = rho >> 4, i = rho & 15; return 8 * (i >> 2) + 4 * n + (i & 3); }

struct GUnit { const char* A; const char* B; int nt; int pm, pn, aux; };

template <bool GATH, class Sched> __device__ __forceinline__ unsigned arow_off(const Sched& S, const GUnit& u, int r, int lda_b) {
    if constexpr (GATH) return (unsigned)S.arow(u, r); else return (unsigned)(r * lda_b);
}
template <class Epi, class Sched, bool GATH = false, bool ACCINIT = false, bool CARRY = false, bool EARLY = false, bool HOOK = false>
__device__ __forceinline__ void gemm_phase(const int wave_, LAS unsigned char* lds, const int lda_b, const int ldb_b, const Sched& S, const Epi& E) {
    const int wid = wave_, lane = lane_id(), tid = wid * 64 + lane, wr = wid >> 2, wc = wid & 3, fr = lane & 15, fq = lane >> 4;
    int sR[2], sC[2];
    unsigned voffA[2][2], voffB[2];
#pragma unroll
    for (int i = 0; i < 2; ++i) { int R, C; stage_rc(tid * 16 + i * 8192, R, C); sR[i] = R; sC[i] = C; const int Rb = (R & ~31) + perm32(R & 31);
        voffB[i] = (unsigned)(Rb * ldb_b + C * 2); }
    const size_t kstep = (size_t)(BK * 2);
    const size_t hstepB = (size_t)HALF * ldb_b;
    const size_t pstepB = (size_t)64 * ldb_b, pstepA = (size_t)64 * lda_b;
    const size_t hstepA = GATH ? 0 : (size_t)HALF * lda_b;
#define PG8_H1(v_) (GATH ? (v_)[1] : (v_)[0])
    const unsigned ldsw = (unsigned)wid * 1024u;
    const int aoff = lds_byte(wr * 64 + fr, fq * 8), boff = lds_byte(wc * 32 + fr, fq * 8);
#define PG8_SA(b, h) (((b) * 2 + (h)) * HTB)
#define PG8_SB(b, h) ((4 + (b) * 2 + (h)) * HTB)
#define PG8_STAGE(bufoff, gbase, voff) do { _Pragma("unroll") for (int _i = 0; _i < 2; ++_i) \
        __builtin_amdgcn_global_load_lds((const unsigned*)((const char*)(gbase) + (size_t)_i * pstepB + (voff)[0]), (LAS unsigned*)(lds + (bufoff) + ldsw + _i * 8192), 16, 0, 0); } while (0)
#define PG8_STAGEA(bufoff, gbase, voff) do { _Pragma("unroll") for (int _i = 0; _i < 2; ++_i) \
        __builtin_amdgcn_global_load_lds((const unsigned*)((const char*)(gbase) + (GATH ? (size_t)0 : (size_t)_i * pstepA) + (GATH ? (voff)[_i] : (voff)[0])), (LAS unsigned*)(lds + (bufoff) + ldsw + _i * 8192), 16, 0, 0); } while (0)
#define PG8_LDA(dst, b, h) do { _Pragma("unroll") for (int m = 0; m < 4; ++m) _Pragma("unroll") for (int k = 0; k < 2; ++k) dst[m][k] = *(const LAS bf16x8*)(lds + PG8_SA(b, h) + aoff + m * 2048 + k * 1024); } while (0)
#define PG8_LDB(dst, b, h) do { _Pragma("unroll") for (int n = 0; n < 2; ++n) _Pragma("unroll") for (int k = 0; k < 2; ++k) dst[n][k] = *(const LAS bf16x8*)(lds + PG8_SB(b, h) + boff + n * 2048 + k * 1024); } while (0)
#define PG8_MMA(ai, bj, At, Bt) do { __builtin_amdgcn_s_setprio(1); _Pragma("unroll") for (int m = 0; m < 4; ++m) _Pragma("unroll") for (int n = 0; n < 2; ++n) _Pragma("unroll") for (int k = 0; k < 2; ++k) \
        acc[ai][bj][m][n] = __builtin_amdgcn_mfma_f32_16x16x32_bf16(Bt[n][k], At[m][k], acc[ai][bj][m][n], 0, 0, 0); __builtin_amdgcn_s_setprio(0); } while (0)
#define PG8_WAIT_V(n) asm volatile("s_waitcnt vmcnt(" #n ")" ::: "memory")
#define PG8_WAIT_L(n) asm volatile("s_waitcnt lgkmcnt(" #n ")" ::: "memory")
#define PG8_BAR __builtin_amdgcn_s_barrier()
#define PG8_SCHED __builtin_amdgcn_sched_barrier(0)
#define PG8_VOFFA(dst, u) do { _Pragma("unroll") for (int _h = 0; _h < 2; ++_h) _Pragma("unroll") for (int _i = 0; _i < 2; ++_i) \
        dst[_h][_i] = arow_off<GATH>(S, u, _h * HALF + sR[_i], lda_b) + (unsigned)(sC[_i] * 2); } while (0)
    GUnit cur, nxt; int ui = 0; bool post = false; (void)post;
    if (!S.next(0, cur)) return;
    f32x4 acc[2][2][4][2];
    if constexpr (ACCINIT) { E.init(acc, cur, wr, wc, fr, fq); E.after_init(); }
    else {
#pragma unroll
    for (int a = 0; a < 2; ++a)
#pragma unroll
        for (int b = 0; b < 2; ++b)
#pragma unroll
            for (int m = 0; m < 4; ++m)
#pragma unroll
                for (int n = 0; n < 2; ++n) acc[a][b][m][n] = (f32x4){0.f, 0.f, 0.f, 0.f};
    }
    bf16x8 At[4][2], B0[2][2], B1[2][2];
    const char* cA = cur.A; const char* cB = cur.B;
    PG8_VOFFA(voffA, cur);
    unsigned voffN[2][2];
#pragma unroll
    for (int h = 0; h < 2; ++h)
#pragma unroll
        for (int i = 0; i < 2; ++i) voffN[h][i] = voffA[h][i];
    PG8_STAGE(PG8_SB(0, 0), cB, voffB); PG8_STAGE(PG8_SB(0, 1), cB + hstepB, voffB); PG8_STAGEA(PG8_SA(0, 0), cA, voffA[0]); PG8_STAGEA(PG8_SA(0, 1), cA + hstepA, PG8_H1(voffA));
    if (wr == 1) PG8_BAR;
    PG8_WAIT_V(2); PG8_BAR;
    PG8_STAGE(PG8_SB(1, 0), cB + kstep, voffB); PG8_STAGEA(PG8_SA(1, 0), cA + kstep, voffA[0]); PG8_STAGE(PG8_SB(1, 1), cB + hstepB + kstep, voffB);
    PG8_WAIT_V(6); PG8_BAR;
    for (;;) {
        const bool has_next = S.next(ui + 1, nxt);
        const char* nA = has_next ? nxt.A : cA; const char* nB = has_next ? nxt.B : cB;
        if (GATH) { if (has_next) PG8_VOFFA(voffN, nxt); }
        const int nt = cur.nt;
        for (int t = 0; t < nt; t += 2) {
            const bool last = (t == nt - 2);
            const char* a1 = cA + (size_t)(t + 1) * kstep;
            const char* a2 = last ? nA : cA + (size_t)(t + 2) * kstep; const char* b2 = last ? nB : cB + (size_t)(t + 2) * kstep;
            const char* a3 = a2 + kstep; const char* b3 = b2 + kstep;
            unsigned vA2[2][2];
#pragma unroll
            for (int h = 0; h < 2; ++h)
#pragma unroll
                for (int i = 0; i < 2; ++i) vA2[h][i] = (GATH && last) ? voffN[h][i] : voffA[h][i];
            const bool relaxed = EARLY && post && t == 0;
#define PG8_WAIT_VX(NR) do { if (relaxed) PG8_WAIT_V(NR); else PG8_WAIT_V(8); } while (0)
            PG8_LDB(B0, 0, 0); PG8_LDB(B1, 0, 1); PG8_SCHED; PG8_LDA(At, 0, 0); if (!relaxed) PG8_STAGEA(PG8_SA(1, 1), a1 + hstepA, PG8_H1(voffA));
            PG8_WAIT_VX(26); PG8_WAIT_L(0); PG8_BAR; PG8_MMA(0, 0, At, B0); PG8_MMA(0, 1, At, B1); PG8_BAR; PG8_SCHED;
            PG8_LDA(At, 0, 1); PG8_STAGE(PG8_SB(0, 0), b2, voffB); PG8_STAGE(PG8_SB(0, 1), b2 + hstepB, voffB); PG8_STAGEA(PG8_SA(0, 0), a2, vA2[0]);
            PG8_WAIT_VX(30); PG8_WAIT_L(0); PG8_BAR; PG8_MMA(1, 0, At, B0); PG8_MMA(1, 1, At, B1); PG8_BAR; PG8_SCHED;
            PG8_LDB(B0, 1, 0); PG8_LDB(B1, 1, 1); PG8_SCHED; PG8_LDA(At, 1, 0); PG8_STAGEA(PG8_SA(0, 1), a2 + hstepA, PG8_H1(vA2));
            PG8_WAIT_VX(26); PG8_WAIT_L(0); PG8_BAR; PG8_MMA(0, 0, At, B0); PG8_MMA(0, 1, At, B1); PG8_BAR; PG8_SCHED;
            PG8_LDA(At, 1, 1); PG8_STAGE(PG8_SB(1, 0), b3, voffB); PG8_STAGE(PG8_SB(1, 1), b3 + hstepB, voffB); PG8_STAGEA(PG8_SA(1, 0), a3, vA2[0]);
            PG8_WAIT_VX(30); PG8_WAIT_L(0); PG8_BAR; PG8_MMA(1, 0, At, B0); PG8_MMA(1, 1, At, B1); PG8_BAR; PG8_SCHED;
#undef PG8_WAIT_VX
        }
        if (wr == 0) PG8_BAR;
        if constexpr (EARLY) { post = has_next && E.nstores(cur) >= 16;
            if (post) PG8_STAGEA(PG8_SA(1, 1), nA + kstep + hstepA, (GATH ? voffN[1] : voffA[0])); }
        bool carried = false;
        const int le_ = lane_id(), fre = le_ & 15, fqe = le_ >> 4;
        if constexpr (CARRY) { if (has_next && E.carry(cur)) { E.rescale(acc, cur, wr, wc, fre, fqe); carried = true; } }
        if (!carried) E(acc, cur, wr, wc, fre, fqe);
        if (!has_next) break;
        if constexpr (ACCINIT) E.init(acc, nxt, wr, wc, fre, fqe);
        else if (!carried) {
#pragma unroll
        for (int a = 0; a < 2; ++a)
#pragma unroll
            for (int b = 0; b < 2; ++b)
#pragma unroll
                for (int m = 0; m < 4; ++m)
#pragma unroll
                    for (int n = 0; n < 2; ++n) acc[a][b][m][n] = (f32x4){0.f, 0.f, 0.f, 0.f};
        }
        if constexpr (HOOK) E.after_unit(cur);
        cur = nxt; cA = nA; cB = nB; ++ui;
        if (GATH) {
#pragma unroll
            for (int h = 0; h < 2; ++h)
#pragma unroll
                for (int i = 0; i < 2; ++i) voffA[h][i] = voffN[h][i];
        }
        if (wr == 1) PG8_BAR;
    }
    PG8_WAIT_V(0);
    PG8_BAR;
#undef PG8_SA
#undef PG8_SB
#undef PG8_STAGE
#undef PG8_STAGEA
#undef PG8_LDA
#undef PG8_LDB
#undef PG8_MMA
#undef PG8_WAIT_V
#undef PG8_WAIT_L
#undef PG8_BAR
#undef PG8_SCHED
#undef PG8_VOFFA
#undef PG8_H1
}
struct TileOrder {
    int nM, nN, nwg, G, c;
    __device__ __forceinline__ void init(int nM_, int nN_, int G_, int c_) { nM = nM_; nN = nN_; nwg = nM * nN; G = G_; c = c_; }
    __device__ __forceinline__ bool tile(int i, int& pm, int& pn) const {
        const long Lq = (long)i * G + c; if (Lq >= nwg) return false;
        int wgid = (int)Lq; { const int q = nwg / 8, r = nwg % 8, xcd = wgid % 8, off = wgid / 8; wgid = (xcd < r ? xcd * (q + 1) : r * (q + 1) + (xcd - r) * q) + off; }
        const int nig = 8 * nN, gid = wgid / nig, fm = gid * 8, gsz = (nM - fm) < 8 ? (nM - fm) : 8;
        pm = fm + ((wgid % nig) % gsz); pn = (wgid % nig) / gsz; return true;
    }
};
}
}
namespace mk { namespace at {
constexpr int SHM_K = 64 * 192 * 2, SHM_V = 64 * 128 * 2;
constexpr int LDS_V = 0, LDS_K = 2 * SHM_V, LDS_WS = LDS_K + 2 * SHM_K, LDS_QR = LDS_WS + 8 * 256, LDS_TOTAL = LDS_QR + 8 * 4096;
constexpr float THRL = 11.5f;
#define KSWZ(row, colB) ((row) * 256 + ((colB) ^ (((row) & 15) << 4)))
#define SBAR() __builtin_amdgcn_sched_barrier(0)
__device__ __forceinline__ int v_st(int k, int c) { const int kk = (k & ~0xC) | ((k & 4) << 1) | ((k & 8) >> 1); return ((kk >> 3) * 4 + (c >> 5)) * 512 + ((kk & 7) * 32 + (c & 31)) * 2; }
__device__ __forceinline__ int v_rd_base(int lane) { return ((lane & 3) << 3) | (((lane >> 2) & 3) << 6) | (((lane >> 4) & 1) << 5) | (((lane >> 5) & 1) << 8); }
constexpr int v_rd_off(int d0, int ks, int half) { return d0 * 512 + ks * 4096 + half * 2048; }
__device__ __forceinline__ int crow(int r, int hi) { return (r & 3) + 8 * (r >> 2) + 4 * hi; }

__device__ __forceinline__ void mask_causal(f32x16& p0, f32x16& p1, int dq) {
    const float NEG = -__builtin_inff();
#pragma unroll
    for (int r = 0; r < 16; ++r) { const int c = (r & 3) + 8 * (r >> 2); if (dq - c < 0) p0[r] = NEG; if (dq - c - 32 < 0) p1[r] = NEG; }
}
__device__ __forceinline__ void mask_meta(f32x16& p0, f32x16& p1) {
    const float NEG = -__builtin_inff();
#pragma unroll
    for (int r = 0; r < 16; ++r) { if (r >= 8) p0[r] = NEG; p1[r] = NEG; }
}
__device__ __forceinline__ void partialSM(f32x16& p0, f32x16& p1, float& m_reg, float& alpha) {
    float pmax = p0[0];
#pragma unroll
    for (int r = 1; r < 16; ++r) pmax = fmaxf(pmax, p0[r]);
#pragma unroll
    for (int r = 0; r < 16; ++r) pmax = fmaxf(pmax, p1[r]);
    { auto rr = __builtin_amdgcn_permlane32_swap(__float_as_uint(pmax), __float_as_uint(pmax), false, false);
      pmax = fmaxf(__uint_as_float(rr[0]), __uint_as_float(rr[1])); }
    float mn;
    if (__builtin_expect(__all((pmax - m_reg) <= THRL), 1)) { mn = m_reg; alpha = 1.f; }
    else { mn = fmaxf(m_reg, pmax); alpha = __builtin_amdgcn_exp2f(m_reg - mn); m_reg = mn; }
#pragma unroll
    for (int r = 0; r < 16; ++r) p0[r] = __builtin_amdgcn_exp2f(p0[r] - mn);
#pragma unroll
    for (int r = 0; r < 16; ++r) p1[r] = __builtin_amdgcn_exp2f(p1[r] - mn);
}
__device__ __forceinline__ void finishSM(const f32x16& p0, const f32x16& p1, float alpha, float& l_reg, bf16x8& pa0, bf16x8& pa1, bf16x8& pa2, bf16x8& pa3) {
    float ps = 0.f;
#pragma unroll
    for (int r = 0; r < 16; ++r) ps += p0[r];
#pragma unroll
    for (int r = 0; r < 16; ++r) ps += p1[r];
    { auto rr = __builtin_amdgcn_permlane32_swap(__float_as_uint(ps), __float_as_uint(ps), false, false);
      ps = __uint_as_float(rr[0]) + __uint_as_float(rr[1]); }
    l_reg = l_reg * alpha + ps;
#define PK4(P, B_, OUT) do { unsigned a0 = cvtpk(P[B_+0], P[B_+1]), a1 = cvtpk(P[B_+2], P[B_+3]);                          \
        unsigned b0 = cvtpk(P[B_+4], P[B_+5]), b1 = cvtpk(P[B_+6], P[B_+7]);                                             \
        auto r0 = __builtin_amdgcn_permlane32_swap(a0, b0, false, false); auto r1 = __builtin_amdgcn_permlane32_swap(a1, b1, false, false); \
        u32x4 w = {r0[0], r1[0], r0[1], r1[1]}; OUT = __builtin_bit_cast(bf16x8, w); } while (0)
    PK4(p0, 0, pa0); PK4(p0, 8, pa1); PK4(p1, 0, pa2); PK4(p1, 8, pa3);
#undef PK4
}
template <int KB>
__device__ __forceinline__ void qkt(f32x16& p0, f32x16& p1, const LAS unsigned char* K_lds, int r32, int hi, const bf16x8* qr, const LAS unsigned char* qrl) {
    p0 = f32x16{}; p1 = f32x16{};
    const unsigned kb0 = (unsigned)(size_t)(K_lds + KB * SHM_K) + (unsigned)KSWZ(r32, hi * 16);
    const int f = (r32 >> 1) & 7;
    const LAS unsigned char* krp = K_lds + KB * SHM_K + 16384 + r32 * 128;
#define KLD(d0, h) ((d0) < 8 ? *(const LAS bf16x8*)((size_t)(kb0 ^ (unsigned)((d0) << 5)) + (h) * 32 * 256) \
                             : *(const LAS bf16x8*)(krp + (((((d0) - 8) * 2 + hi) ^ f) << 4) + (h) * 32 * 128))
#define QLD(d0) (*(const LAS bf16x8*)(qrl + (((((d0) - 8) * 2 + hi) ^ f) << 4)))
    bf16x8 ka00, ka01, ka10, ka11, qa0, qa1;
    ka00 = KLD(0, 0); ka01 = KLD(0, 1); ka10 = KLD(1, 0); ka11 = KLD(1, 1);
    __builtin_amdgcn_sched_group_barrier(0x100, 4, 0);
#define QSTEP(d0, A0, A1, QV, NRD) do { \
        p0 = __builtin_amdgcn_mfma_f32_32x32x16_bf16(A0, QV, p0, 0, 0, 0); \
        p1 = __builtin_amdgcn_mfma_f32_32x32x16_bf16(A1, QV, p1, 0, 0, 0); \
        if ((d0) + 2 < 12) { A0 = KLD((d0) + 2, 0); A1 = KLD((d0) + 2, 1); } \
        __builtin_amdgcn_sched_group_barrier(0x008, 2, 0); \
        if ((NRD) > 0) __builtin_amdgcn_sched_group_barrier(0x100, NRD, 0); } while (0)
    QSTEP(0, ka00, ka01, qr[0], 2); QSTEP(1, ka10, ka11, qr[1], 2); QSTEP(2, ka00, ka01, qr[2], 2); QSTEP(3, ka10, ka11, qr[3], 2);
    QSTEP(4, ka00, ka01, qr[4], 2); QSTEP(5, ka10, ka11, qr[5], 2);
    qa0 = QLD(8); QSTEP(6, ka00, ka01, qr[6], 3);
    qa1 = QLD(9); QSTEP(7, ka10, ka11, qr[7], 3);
    { const bf16x8 q8 = qa0; qa0 = QLD(10); QSTEP(8, ka00, ka01, q8, 3); }
    { const bf16x8 q9 = qa1; qa1 = QLD(11); QSTEP(9, ka10, ka11, q9, 3); }
    QSTEP(10, ka00, ka01, qa0, 0); QSTEP(11, ka10, ka11, qa1, 0);
#undef QSTEP
#undef KLD
#undef QLD
}
template <int VB>
__device__ __forceinline__ void pv_tile(f32x16* o, int vb0, bf16x8 pa0, bf16x8 pa1, bf16x8 pa2, bf16x8 pa3) {
#define TRRD(dst, off) asm volatile("ds_read_b64_tr_b16 %0, %1 offset:%2" : "=&v"(dst) : "v"(vb0), "i"(off) : "memory")
#define PV_RD(S, d0) do { constexpr int b_ = VB * SHM_V + v_rd_off(d0, 0, 0); \
        TRRD(S##l0, b_); TRRD(S##h0, b_ + 2048); TRRD(S##l1, b_ + 4096); TRRD(S##h1, b_ + 6144); TRRD(S##l2, b_ + 8192); TRRD(S##h2, b_ + 10240); TRRD(S##l3, b_ + 12288); TRRD(S##h3, b_ + 14336); } while (0)
#define PV_MM(S, d0) do { \
        o[d0] = __builtin_amdgcn_mfma_f32_32x32x16_bf16(pa0, (bf16x8){S##l0[0], S##l0[1], S##l0[2], S##l0[3], S##h0[0], S##h0[1], S##h0[2], S##h0[3]}, o[d0], 0, 0, 0);   \
        o[d0] = __builtin_amdgcn_mfma_f32_32x32x16_bf16(pa1, (bf16x8){S##l1[0], S##l1[1], S##l1[2], S##l1[3], S##h1[0], S##h1[1], S##h1[2], S##h1[3]}, o[d0], 0, 0, 0);   \
        o[d0] = __builtin_amdgcn_mfma_f32_32x32x16_bf16(pa2, (bf16x8){S##l2[0], S##l2[1], S##l2[2], S##l2[3], S##h2[0], S##h2[1], S##h2[2], S##h2[3]}, o[d0], 0, 0, 0);   \
        o[d0] = __builtin_amdgcn_mfma_f32_32x32x16_bf16(pa3, (bf16x8){S##l3[0], S##l3[1], S##l3[2], S##l3[3], S##h3[0], S##h3[1], S##h3[2], S##h3[3]}, o[d0], 0, 0, 0); } while (0)
#define PV_WAIT(N, S) asm volatile("s_waitcnt lgkmcnt(" #N ")" : "+v"(S##l0), "+v"(S##h0), "+v"(S##l1), "+v"(S##h1), "+v"(S##l2), "+v"(S##h2), "+v"(S##l3), "+v"(S##h3) :: "memory")
    s16x4 Al0, Al1, Al2, Al3, Ah0, Ah1, Ah2, Ah3, Bl0, Bl1, Bl2, Bl3, Bh0, Bh1, Bh2, Bh3;
    PV_RD(A, 0); PV_RD(B, 1);
    PV_WAIT(8, A); SBAR(); PV_MM(A, 0); SBAR();
    PV_RD(A, 2);
    PV_WAIT(8, B); SBAR(); PV_MM(B, 1); SBAR();
    PV_RD(B, 3);
    PV_WAIT(8, A); SBAR(); PV_MM(A, 2); SBAR();
    PV_WAIT(0, B); SBAR(); PV_MM(B, 3);
#undef PV_RD
#undef PV_MM
#undef PV_WAIT
#undef TRRD
}

__device__ __forceinline__ void attn_unit(const int wave_, int h, int qb, unsigned char* ws, unsigned wsQ, unsigned wsK, unsigned wsV, unsigned wsO, unsigned wsKR, LAS unsigned char* lds) {
    const int wid = wave_, lane = lane_id(), r32 = lane & 31, hi = lane >> 5;
    LAS unsigned char* V_lds = lds + LDS_V; LAS unsigned char* K_lds = lds + LDS_K;
    LAS float* wsf = (LAS float*)(lds + LDS_WS) + wid * 64; LAS float* li_l = wsf; LAS float* al_l = wsf + 32;
    const int NTT = 4 * qb + 5;
    const int qlo = qb * 256 + wid * 32, qrow = qlo + r32;
    const int vb0 = (int)(size_t)V_lds + v_rd_base(lane);
    unsigned kn_off[2], v_off[2], kr_off;
#pragma unroll
    for (int j = 0; j < 2; ++j) { const int piece = j * 8 + wid;
        { const int row = piece * 4 + (lane >> 4), c = (lane & 15) ^ (row & 15); kn_off[j] = (unsigned)(row * QKD + c * 8) * 2u; }
        { const int sub = piece * 2 + (lane >> 5), kk = (sub >> 2) * 8 + ((lane & 31) >> 2), k = (kk & ~0xC) | ((kk & 4) << 1) | ((kk & 8) >> 1); v_off[j] = (unsigned)(k * VD + (sub & 3) * 32 + (lane & 3) * 8) * 2u; } }
    { const int row = wid * 8 + (lane >> 3), c = (lane & 7) ^ ((row >> 1) & 7); kr_off = (unsigned)(row * 64 + c * 8) * 2u; }
    LAS unsigned char* ldsA = lds;
#define KVROW(tt) ((tt) == 0 ? SEQ : ((tt) - 1) * 64)
#define SLOAD(tt, bf) do { const unsigned char* kp_ = ws + (wsK + (unsigned)(h * KROWS + KVROW(tt)) * (QKD * 2u)); const unsigned char* vp_ = ws + (wsV + (unsigned)(h * KROWS + KVROW(tt)) * (VD * 2u)); \
        const unsigned char* rp_ = ws + (wsKR + (unsigned)KVROW(tt) * 128u); \
        _Pragma("unroll") for (int j_ = 0; j_ < 2; ++j_) { \
            __builtin_amdgcn_global_load_lds((const unsigned*)(kp_ + kn_off[j_]), (LAS unsigned*)(ldsA + LDS_K + (bf) * SHM_K + (j_ * 8 + wid) * 1024), 16, 0, 0); \
            __builtin_amdgcn_global_load_lds((const unsigned*)(vp_ + v_off[j_]), (LAS unsigned*)(ldsA + LDS_V + (bf) * SHM_V + (j_ * 8 + wid) * 1024), 16, 0, 0); } \
        __builtin_amdgcn_global_load_lds((const unsigned*)(rp_ + kr_off), (LAS unsigned*)(ldsA + LDS_K + (bf) * SHM_K + 16384 + wid * 1024), 16, 0, 0); } while (0)
    SLOAD(0, 0);
    bf16x8 qr[8];
    LAS unsigned char* qrl = lds + LDS_QR + wid * 4096 + r32 * 128;
    { const bf16_t* Qw = (const bf16_t*)(ws + wsQ) + ((size_t)h * SEQ + qrow) * QKD + hi * 8;
#pragma unroll
      for (int d0 = 0; d0 < 8; ++d0) qr[d0] = *(const bf16x8*)(Qw + d0 * 16);
      const int f_ = (r32 >> 1) & 7;
#pragma unroll
      for (int dd = 0; dd < 4; ++dd) { const bf16x8 t = *(const bf16x8*)(Qw + 128 + dd * 16); *(LAS bf16x8*)(qrl + (((dd * 2 + hi) ^ f_) << 4)) = t; } }
    asm volatile("s_waitcnt vmcnt(0)" ::: "memory");
    __syncthreads();
    float m_reg = -1e30f, l_reg = 0.f; f32x16 o[4] = {};
    f32x16 p0, p1; bf16x8 pa0, pa1, pa2, pa3;
#define STEP(tt, KB) do { \
        if ((tt) + 1 < NTT) SLOAD((tt) + 1, (KB) ^ 1); \
        const int kbase_ = ((tt) - 1) * 64; \
        const bool act_ = (tt) == 0 || kbase_ <= qlo + 31;               \
        if (act_) { \
            SBAR(); qkt<KB>(p0, p1, K_lds, r32, hi, qr, qrl); \
            if ((tt) == 0) mask_meta(p0, p1); else if (kbase_ + 63 > qlo) mask_causal(p0, p1, qrow - kbase_ - 4 * hi); \
            float alpha_; partialSM(p0, p1, m_reg, alpha_); \
            if (__any(alpha_ < 1.f)) { if (hi == 0) al_l[r32] = alpha_; asm volatile("s_waitcnt lgkmcnt(0)" ::: "memory"); \
                _Pragma("unroll") for (int d_ = 0; d_ < 4; ++d_) _Pragma("unroll") for (int r = 0; r < 16; ++r) o[d_][r] *= al_l[crow(r, hi)]; } \
            finishSM(p0, p1, alpha_, l_reg, pa0, pa1, pa2, pa3); SBAR(); \
            pv_tile<KB>(o, vb0, pa0, pa1, pa2, pa3); \
        } \
        asm volatile("s_waitcnt vmcnt(0)" ::: "memory"); \
        __syncthreads(); } while (0)
    int tt = 0;
    for (; tt + 1 < NTT; tt += 2) { STEP(tt, 0); STEP(tt + 1, 1); }
    STEP(tt, 0);
    if (hi == 0) li_l[r32] = l_reg;
    asm volatile("s_waitcnt lgkmcnt(0)" ::: "memory");
    bf16_t* Ow = (bf16_t*)(ws + wsO) + (size_t)qlo * D + h * VD;
#pragma unroll
    for (int r = 0; r < 16; ++r) { const int orow = crow(r, hi); const float rl = __builtin_amdgcn_rcpf(li_l[orow]);
#pragma unroll
        for (int d0 = 0; d0 < 4; ++d0) { const float v = o[d0][r] * rl; const float vn = __shfl_xor(v, 1);
            if ((r32 & 1) == 0) *(unsigned*)(Ow + (size_t)orow * D + d0 * 32 + r32) = cvtpk(v, vn); } }
    __syncthreads();
#undef STEP
#undef SLOAD
#undef KVROW
}
#undef KSWZ
#undef SBAR
}}
namespace mk { namespace m4 {
constexpr int HDN_SLOTS = 16384 + 256;
constexpr int ROWS = 384, A_ST = ROWS * 64, RAW_ST = 16384, IMG_ST = 8192, NRAW = 4;
constexpr int LDS_A = 0, LDS_RAW = 3 * A_ST, LDS_IMG = LDS_RAW + NRAW * RAW_ST, LDS_TOTAL = LDS_IMG + 2 * IMG_ST;
__device__ __forceinline__ int invperm32(int c) { return 16 * ((c >> 2) & 1) + 4 * (c >> 3) + (c & 3); }
__device__ __forceinline__ int swz(int ob) { return ob ^ (((ob >> 9) & 1) << 5); }
struct MUnit { const char* A; const float* B0; const float* B1; int nK; int pm, aux, ns, koff; };
struct UState { const char* asrc; const char* bsrc; unsigned voffA[3]; int wact; };
template <int MODE, class Sched, class Epi, int ABL = 0>
__device__ __forceinline__ void moe_phase(const int wave_, LAS unsigned char* lds, const Sched& S, const Epi& E, const float* kscale, const XcdBarrier sbar = XcdBarrier{nullptr, 0u, nullptr}, const bool do_wait = false) {
    (void)kscale;
    const int wid = wave_, lane = lane_id(), tid = wid * 64 + lane, fr = lane & 15, fq = lane >> 4;
    constexpr int LDB = MODE == 0 ? 512 : 2048;
    constexpr int LDA = MODE == 0 ? 4096 : 64;
    constexpr size_t KSTR = MODE == 0 ? 64 : (size_t)HDN_SLOTS * 64;
    const unsigned ldsb = (unsigned)(size_t)lds;
    const int ob_ = swz(lane * 16), arr = ob_ >> 6, acc8 = (ob_ & 63) >> 1;
    unsigned voffB[2];
#pragma unroll
    for (int q = 0; q < 2; ++q) voffB[q] = MODE == 0 ? (unsigned)(((8 * (wid & 3) + 4 * q + (lane >> 4)) * LDB + 4 * (lane & 15)) * 4) : (unsigned)(((4 * wid + 2 * q + (lane >> 5)) * LDB + 4 * (lane & 31)) * 4);
    const int which = MODE == 0 ? (wid >> 2) : 0;
    const int bk4 = MODE == 0 ? 2 * (wid & 3) + (lane >> 5) : wid;
    const int bcol = MODE == 0 ? 2 * (lane & 31) : 2 * lane;
    const unsigned rawoff = MODE == 0 ? (unsigned)(which * 8192 + (bk4 * 4) * 256 + bcol * 4) : (unsigned)((bk4 * 4) * 512 + bcol * 4);
    constexpr int RAWP = MODE == 0 ? 256 : 512;
    unsigned bwoff[2];
#pragma unroll
    for (int jj = 0; jj < 2; ++jj) { const int n = MODE == 0 ? 2 * (bcol + jj) + which : bcol + jj; const int rho = (n & ~31) + invperm32(n & 31); bwoff[jj] = (unsigned)((rho >> 4) * 1024 + swz((rho & 15) * 64 + bk4 * 8)); }
    const int afoff = swz(fr * 64 + fq * 16);
#define M4_USTATE(US, U) do { (US).wact = (wid * 48 < (U).aux - (U).pm) ? 1 : 0; \
        _Pragma("unroll") for (int p_ = 0; p_ < 3; ++p_) { const int r_ = wid * 48 + p_ * 16 + arr; (US).voffA[p_] = (MODE == 0 ? S.arow(U, r_) : (unsigned)(r_ * LDA)) + (unsigned)(acc8 * 2); } \
        { const unsigned long long bb_ = (unsigned long long)((MODE == 0 && wid >= 4) ? (U).B1 : (U).B0), aa_ = (unsigned long long)(U).A; \
          (US).bsrc = (const char*)(((unsigned long long)(unsigned)__builtin_amdgcn_readfirstlane((int)(bb_ >> 32)) << 32) | (unsigned)__builtin_amdgcn_readfirstlane((int)bb_)); \
          (US).asrc = (const char*)(((unsigned long long)(unsigned)__builtin_amdgcn_readfirstlane((int)(aa_ >> 32)) << 32) | (unsigned)__builtin_amdgcn_readfirstlane((int)aa_)); } } while (0)
#define M4_DMA(voff, dst, base, NT) do { unsigned keep_; const unsigned d_ = (unsigned)__builtin_amdgcn_readfirstlane((int)(dst)); \
        if (NT) asm volatile("s_mov_b32 %0, m0\n\ts_mov_b32 m0, %2\n\ts_nop 0\n\tglobal_load_lds_dwordx4 %1, %3 nt\n\ts_mov_b32 m0, %0" : "=&s"(keep_) : "v"(voff), "s"(d_), "s"(base) : "memory"); \
        else asm volatile("s_mov_b32 %0, m0\n\ts_mov_b32 m0, %2\n\ts_nop 0\n\tglobal_load_lds_dwordx4 %1, %3\n\ts_mov_b32 m0, %0" : "=&s"(keep_) : "v"(voff), "s"(d_), "s"(base) : "memory"); } while (0)
#define M4_STAGEA(US, k, st) do { if (!(ABL & 4) && (US).wact) { const char* ab_ = (US).asrc + (size_t)(k) * KSTR; _Pragma("unroll") for (int p_ = 0; p_ < 3; ++p_) M4_DMA((US).voffA[p_], ldsb + LDS_A + (st) * A_ST + (3 * wid + p_) * 1024, ab_, 0); } } while (0)
#define M4_STAGEB(US, k, st) do { if (!(ABL & 2)) { const char* bb_ = (US).bsrc + (size_t)(k) * (32 * LDB * 4); _Pragma("unroll") for (int q_ = 0; q_ < 2; ++q_) M4_DMA(voffB[q_], ldsb + LDS_RAW + (st) * RAW_ST + (2 * wid + q_) * 1024, bb_, 1); } } while (0)
#define M4_CONVERT(st, buf) do { f32x2 r_[4]; _Pragma("unroll") for (int i_ = 0; i_ < 4; ++i_) r_[i_] = *(const LAS f32x2*)(lds + LDS_RAW + (st) * RAW_ST + rawoff + i_ * RAWP); \
        _Pragma("unroll") for (int jj_ = 0; jj_ < 2; ++jj_) { u32x2 w_; w_.x = cvtpk(r_[0][jj_], r_[1][jj_]); w_.y = cvtpk(r_[2][jj_], r_[3][jj_]); \
            *(LAS u32x2*)(lds + LDS_IMG + (buf) * IMG_ST + bwoff[jj_]) = w_; } } while (0)
#define M4_COMPUTE(st, buf) do { if (!(ABL & 1) && cur.wact) { bf16x8 Af[3], Bf[8]; \
        _Pragma("unroll") for (int m = 0; m < 3; ++m) Af[m] = *(const LAS bf16x8*)(lds + LDS_A + (st) * A_ST + (3 * wid + m) * 1024 + afoff); \
        _Pragma("unroll") for (int n = 0; n < 8; ++n) Bf[n] = *(const LAS bf16x8*)(lds + LDS_IMG + (buf) * IMG_ST + n * 1024 + afoff); \
        _Pragma("unroll") for (int m = 0; m < 3; ++m) _Pragma("unroll") for (int n = 0; n < 8; ++n) acc[m][n] = __builtin_amdgcn_mfma_f32_16x16x32_bf16(Bf[n], Af[m], acc[m][n], 0, 0, 0); } } while (0)
#define M4_WAITV(N) asm volatile("s_waitcnt vmcnt(" #N ")" ::: "memory")
    MUnit ucur, unxt; UState cur, nxt;
    if (!S.next(0, ucur)) return;
    const int nK = ucur.nK, kmask = nK - 1;
    int koffc = __builtin_amdgcn_readfirstlane(ucur.koff) & kmask;
    asm volatile("s_waitcnt vmcnt(0)" ::: "memory");
    { const unsigned long long bb_ = (unsigned long long)((MODE == 0 && wid >= 4) ? ucur.B1 : ucur.B0);
      cur.bsrc = (const char*)(((unsigned long long)(unsigned)__builtin_amdgcn_readfirstlane((int)(bb_ >> 32)) << 32) | (unsigned)__builtin_amdgcn_readfirstlane((int)bb_)); }
#pragma unroll
    for (int s_ = 0; s_ < 4; ++s_) M4_STAGEB(cur, (s_ + koffc) & kmask, s_);
    if (do_wait) xcd_wait(sbar);
    M4_USTATE(cur, ucur);
    bool has_next = S.next(1, unxt);
    if (has_next) M4_USTATE(nxt, unxt); else nxt = cur;
    int koffn = has_next ? (__builtin_amdgcn_readfirstlane(unxt.koff) & kmask) : 0;
    int a0 = 0, a1 = 1, a2 = 2, wa0 = cur.wact ? 3 : 0, wa1 = wa0;
    M4_STAGEA(cur, (0 + koffc) & kmask, 0); M4_STAGEA(cur, (1 + koffc) & kmask, 1);
    M4_WAITV(0);
    __builtin_amdgcn_s_barrier();
    M4_CONVERT(0, 0);
    asm volatile("s_waitcnt lgkmcnt(0)" ::: "memory"); __builtin_amdgcn_s_barrier();
    for (int ui = 0;; ++ui) {
        f32x4 acc[3][8];
#pragma unroll
        for (int m = 0; m < 3; ++m)
#pragma unroll
            for (int n = 0; n < 8; ++n) acc[m][n] = (f32x4){0.f, 0.f, 0.f, 0.f};
#define M4_STEP(t, PAR) do { \
            const bool in1_ = (t) + 1 < nK, in2_ = (t) + 2 < nK, in4_ = (t) + 4 < nK; \
            const int wq_ = wa0 + wa1;                                    \
            if (in1_ || has_next) { if (!(ABL & 6)) { if (wq_ == 6) M4_WAITV(10); else if (wq_ == 3) M4_WAITV(7); else M4_WAITV(4); } M4_CONVERT(((t) + 1) & 3, 1 - (PAR)); } \
            int w2_ = 0; \
            if (in2_) { M4_STAGEA(cur, ((t) + 2 + koffc) & kmask, a2); w2_ = cur.wact; } else if (has_next) { M4_STAGEA(nxt, ((t) + 2 - nK + koffn) & kmask, a2); w2_ = nxt.wact; } \
            if (in4_) M4_STAGEB(cur, ((t) + 4 + koffc) & kmask, (t) & 3); else if (has_next) M4_STAGEB(nxt, ((t) + 4 - nK + koffn) & kmask, (t) & 3); \
            __builtin_amdgcn_sched_barrier(0); \
            M4_COMPUTE(a0, PAR); \
            __builtin_amdgcn_sched_barrier(0); \
            if ((in4_ || has_next) && !(ABL & 6)) { if (w2_) M4_WAITV(7); else M4_WAITV(4); } else M4_WAITV(0); \
            asm volatile("s_waitcnt lgkmcnt(0)" ::: "memory"); __builtin_amdgcn_s_barrier(); \
            { const int s_ = a0; a0 = a1; a1 = a2; a2 = s_; wa0 = wa1; wa1 = w2_ ? 3 : 0; } } while (0)
        for (int t = 0; t < nK; t += 2) { M4_STEP(t, 0); M4_STEP(t + 1, 1); }
#undef M4_STEP
        if (!(ABL & 8)) { if (cur.wact) E(acc, ucur, wid, fr, fq); } else { asm volatile("" :: "v"(acc[0][0]), "v"(acc[1][1]), "v"(acc[2][2])); }
        if (!has_next) break;
        ucur = unxt; cur = nxt; koffc = koffn;
        has_next = S.next(ui + 2, unxt);
        if (has_next) { M4_USTATE(nxt, unxt); koffn = __builtin_amdgcn_readfirstlane(unxt.koff) & kmask; }
    }
    M4_WAITV(0);
    __syncthreads();
#undef M4_USTATE
#undef M4_DMA
#undef M4_STAGEA
#undef M4_STAGEB
#undef M4_CONVERT
#undef M4_COMPUTE
#undef M4_WAITV
}
}}
namespace mk {
constexpr size_t MiB = 1u << 20;
constexpr size_t WS_CTL = 0, CTL_ZERO_BYTES = 32768;
constexpr size_t WS_WIN = 2 * MiB;
constexpr size_t WS_WQKV = 28 * MiB;
constexpr size_t WS_WO = 36 * MiB;
constexpr size_t WS_WPE = 44 * MiB;
constexpr size_t WS_WOUT = 52 * MiB;
constexpr size_t WS_WR = 60 * MiB;
constexpr size_t WS_ROPE = 61 * MiB;
constexpr size_t WS_KR = 28 * MiB;
constexpr size_t WS_XN = 64 * MiB;
constexpr size_t WS_XNM = 96 * MiB;
constexpr size_t WS_SSQ = 97 * MiB;
constexpr size_t WS_CQKV = 98 * MiB;
constexpr size_t WS_U = 116 * MiB;
constexpr size_t WS_G = 133 * MiB;
constexpr size_t WS_Q = 197 * MiB;
constexpr size_t WS_K = 245 * MiB;
constexpr size_t WS_V = 294 * MiB;
constexpr size_t WS_O = 327 * MiB;
constexpr size_t WS_PL = 359 * MiB;
constexpr size_t WS_SS2 = 391 * MiB;
constexpr size_t WS_RT = 393 * MiB;
constexpr size_t WS_WPOT = 396 * MiB;
constexpr size_t WS_PWB = 400 * MiB;
constexpr size_t WS_CQKV2 = 404 * MiB;
constexpr size_t WS_WQKV2 = 436 * MiB;
constexpr size_t WS_WED = 652 * MiB;
constexpr size_t WS_END = 780 * MiB;
constexpr int CW_BAR = 4096;
constexpr int WIN_ROWS = 6400;

constexpr int RING_BYTES = 155648, MISC_OFF = RING_BYTES, LDS_BYTES = 163840;

struct Args { const float* in[22]; float* out; unsigned char* ws; int ph_lo, ph_hi, never, pad; };

struct Frame {
    LAS unsigned char* lds; volatile LAS unsigned* MISC;
    int vcu, G, wave;
    unsigned char* ws;
};
struct Ids { int tid, lane, wave; };
__device__ __forceinline__ Ids phase_ids(int wave) { Ids i; i.wave = wave; i.lane = lane_id(); i.tid = wave * 64 + i.lane; return i; }

enum { MAP_ID = 0, MAP_WIN = 1, MAP_UQ = 2, MAP_EVEN = 3, MAP_ODD = 4 };
__device__ __forceinline__ int ileave64(int i) { return i < 32 ? 2 * i : 2 * (i - 32) + 1; }
template <int KIND> __device__ __forceinline__ int map_row(int n) {
    if (KIND == MAP_WIN) { if (n < 1024) return n; if (n < 1088) return 6144 + ileave64(n - 1024); return n - 64; }
    if (KIND == MAP_UQ) { const int h = n / 192, d = n - h * 192; return d < 128 ? n : h * 192 + 128 + ileave64(d - 128); }
    if (KIND == MAP_EVEN) return 2 * n;
    if (KIND == MAP_ODD) return 2 * n + 1;
    return n;
}
template <int KIND> __device__ __forceinline__ void tile_store_T(const LAS float* scr, bf16_t* WT, int ldt, int row_off, int n0, int k0, int lane) {
    const int c = lane & 7;
#pragma unroll
    for (int j = 0; j < 4; ++j) { const int n = (lane >> 3) + 8 * j; const LAS float* s = scr + (8 * c) * 33 + n;
        u32x4 o; o.x = cvtpk(s[0 * 33], s[1 * 33]); o.y = cvtpk(s[2 * 33], s[3 * 33]); o.z = cvtpk(s[4 * 33], s[5 * 33]); o.w = cvtpk(s[6 * 33], s[7 * 33]);
        *(u32x4*)(WT + (size_t)(row_off + map_row<KIND>(n0 + n)) * ldt + k0 + 8 * c) = o; }
    asm volatile("s_waitcnt lgkmcnt(0)" ::: "memory");
}
template <int KIND> __device__ __forceinline__ void p0_transpose_item(const float* W, int N, bf16_t* WT, int ldt, int row_off, const float* kscale, LAS float* scr, int item, int lane) {
    const int nblk = N / 32, kb = item / nblk, nb = item % nblk, k0 = 64 * kb, n0 = 32 * nb;
    float tv[32];
#pragma unroll
    for (int i = 0; i < 32; ++i) { const int kk = 2 * i + (lane >> 5); tv[i] = W[(size_t)(k0 + kk) * N + n0 + (lane & 31)]; }
#pragma unroll
    for (int i = 0; i < 32; ++i) { const int kk = 2 * i + (lane >> 5); float v = tv[i]; if (kscale) v *= kscale[k0 + kk]; scr[kk * 33 + (lane & 31)] = v; }
    asm volatile("s_waitcnt lgkmcnt(0)" ::: "memory");
    tile_store_T<KIND>(scr, WT, ldt, row_off, n0, k0, lane);
}
__device__ __forceinline__ void rms_row_to_bf16(const float* xrow, const float* w, bf16_t* orow, int lane) {
    const f32x4* xr = (const f32x4*)xrow + lane; const f32x4* wr4 = (const f32x4*)w + lane;
    f32x4 v[8]; float s = 0.f;
#pragma unroll
    for (int j = 0; j < 8; ++j) { v[j] = xr[64 * j]; s += (v[j].x * v[j].x + v[j].y * v[j].y) + (v[j].z * v[j].z + v[j].w * v[j].w); }
    const float rstd = rsqrtf(wave_sum(s) * (1.f / D) + EPS);
    u32x2* o8 = (u32x2*)orow + lane;
#pragma unroll
    for (int j = 0; j < 8; ++j) { const f32x4 ww = wr4[64 * j]; u32x2 o; o.x = cvtpk(v[j].x * rstd * ww.x, v[j].y * rstd * ww.y); o.y = cvtpk(v[j].z * rstd * ww.z, v[j].w * rstd * ww.w); o8[64 * j] = o; }
}

__device__ __forceinline__ void rms_row2_to_bf16(const float* x0, const float* x1, const float* w, bf16_t* o0, bf16_t* o1, int lane) {
    const f32x4* xr0 = (const f32x4*)x0 + lane; const f32x4* xr1 = (const f32x4*)x1 + lane; const f32x4* wr4 = (const f32x4*)w + lane;
    f32x4 a[8], b[8]; float s0 = 0.f, s1 = 0.f;
#pragma unroll
    for (int j = 0; j < 8; ++j) { a[j] = xr0[64 * j]; b[j] = xr1[64 * j]; }
#pragma unroll
    for (int j = 0; j < 8; ++j) { s0 += (a[j].x * a[j].x + a[j].y * a[j].y) + (a[j].z * a[j].z + a[j].w * a[j].w); s1 += (b[j].x * b[j].x + b[j].y * b[j].y) + (b[j].z * b[j].z + b[j].w * b[j].w); }
    const float r0 = rsqrtf(wave_sum(s0) * (1.f / D) + EPS), r1 = rsqrtf(wave_sum(s1) * (1.f / D) + EPS);
    u32x2* p0 = (u32x2*)o0 + lane; u32x2* p1 = (u32x2*)o1 + lane;
#pragma unroll
    for (int j = 0; j < 8; ++j) { const f32x4 ww = wr4[64 * j]; u32x2 o; o.x = cvtpk(a[j].x * r0 * ww.x, a[j].y * r0 * ww.y); o.y = cvtpk(a[j].z * r0 * ww.z, a[j].w * r0 * ww.w); p0[64 * j] = o;
        u32x2 q; q.x = cvtpk(b[j].x * r1 * ww.x, b[j].y * r1 * ww.y); q.y = cvtpk(b[j].z * r1 * ww.z, b[j].w * r1 * ww.w); p1[64 * j] = q; }
}
template <int PART> __device__ __forceinline__ void p0_prologue(Frame& F, const Args& a) {
    const Ids I = phase_ids(F.wave);
    LAS float* scr = (LAS float*)(F.lds + I.wave * 16384);
    const int gw = F.vcu * NWAVES + I.wave, NGW = F.G * NWAVES, lane = I.lane;
    unsigned char* ws = F.ws;
    bf16_t* WIN = (bf16_t*)(ws + WS_WIN); bf16_t* WQKV = (bf16_t*)(ws + WS_WQKV2);
    constexpr int I_IN = 32 * (6208 / 32), I_UQ = 8 * (3072 / 32), I_UKV = 8 * (4096 / 32), I_O = 32 * 64, I_OUT = 32 * 64, I_RE = 32 * 2, I_WEFF = 16 * 64;
    if constexpr (PART == 2) { (void)scr; (void)WIN; (void)WQKV; } else if constexpr (PART == 0) {
        for (int it = gw; it < I_IN + I_WEFF; it += NGW) {
            if (it < I_IN) p0_transpose_item<MAP_WIN>(a.in[3], 6208, WIN, 2048, 0, nullptr, scr, it, lane);
            else p0_transpose_item<MAP_ID>(a.in[11], 2048, (bf16_t*)(ws + WS_WPOT), 1024, 0, a.in[10], scr, it - I_IN, lane); }
    } else {
        for (int it = gw; it < I_UQ + I_UKV + I_O + I_OUT + I_RE; it += NGW) {
            int r = it;
            if (r < I_UQ) { p0_transpose_item<MAP_UQ>(a.in[5], 3072, WQKV, 2048, 0, a.in[4], scr, r, lane); continue; } r -= I_UQ;
            if (r < I_UKV) { p0_transpose_item<MAP_ID>(a.in[7], 4096, WQKV, 2048, 3072, a.in[6], scr, r, lane); continue; } r -= I_UKV;
            if (r < I_O) { p0_transpose_item<MAP_ID>(a.in[8], 2048, (bf16_t*)(ws + WS_WO), 2048, 0, nullptr, scr, r, lane); continue; } r -= I_O;
            if (r < I_OUT) { p0_transpose_item<MAP_ID>(a.in[12], 2048, (bf16_t*)(ws + WS_WOUT), 2048, 0, nullptr, scr, r, lane); continue; } r -= I_OUT;
            p0_transpose_item<MAP_ID>(a.in[16], 64, (bf16_t*)(ws + WS_WR), 2048, 8, nullptr, scr, r, lane); }
    }
    if constexpr (PART != 2) { const int gt = gw * 64 + lane, NT = NGW * 64;
      if constexpr (PART == 1) { bf16_t* WR = (bf16_t*)(ws + WS_WR);
        for (int i = gt; i < 8 * 2048; i += NT) { const int n = i >> 11, k = i & 2047; WR[(size_t)n * 2048 + k] = f2bf(a.in[14][(size_t)k * 8 + n]); }
        for (int i = gt; i < (128 - 72) * 2048; i += NT) WR[(size_t)72 * 2048 + i] = 0;
        u32x4* z = (u32x4*)(WIN + (size_t)6208 * 2048);
        for (int i = gt; i < (WIN_ROWS - 6208) * 2048 * 2 / 16; i += NT) z[i] = (u32x4){0u, 0u, 0u, 0u};
        bf16_t* Kb = (bf16_t*)(ws + WS_K); bf16_t* Vb = (bf16_t*)(ws + WS_V);
        for (int i = gt; i < NH * 48 * QKD / 8; i += NT) { const int h = i / (48 * QKD / 8), r = i % (48 * QKD / 8); *(u32x4*)(Kb + ((size_t)h * KROWS + 8208) * QKD + (size_t)r * 8) = (u32x4){0u, 0u, 0u, 0u}; }
        { bf16_t* KRz = (bf16_t*)(ws + WS_KR); for (int i = gt; i < 48 * 64 / 8; i += NT) *(u32x4*)(KRz + (size_t)8208 * 64 + (size_t)i * 8) = (u32x4){0u, 0u, 0u, 0u}; }
        for (int i = gt; i < NH * 48 * VD / 8; i += NT) { const int h = i / (48 * VD / 8), r = i % (48 * VD / 8); *(u32x4*)(Vb + ((size_t)h * KROWS + 8208) * VD + (size_t)r * 8) = (u32x4){0u, 0u, 0u, 0u}; }
      } else {
        { bf16_t* PWB = (bf16_t*)(ws + WS_PWB); for (int i = gt; i < 4 * 256 * 256 / 4; i += NT) { const f32x4 v = *(const f32x4*)(a.in[9] + (size_t)i * 4); u32x2 o; o.x = cvtpk(v[0], v[1]); o.y = cvtpk(v[2], v[3]); *(u32x2*)(PWB + (size_t)i * 4) = o; } }
        f32x2* RT = (f32x2*)(ws + WS_ROPE);
        for (int i = gt; i < LTOT * 32; i += NT) { const int pos = i >> 5, ii = i & 31; float s_, c_; sincosf((float)pos * (1.0f / powf(10000.f, (float)(2 * ii) / 64.f)), &s_, &c_); RT[i] = (f32x2){c_, s_}; }
      }
    }
    if constexpr (PART != 2) return;
    { const f32x4* wr4 = (const f32x4*)a.in[2] + lane; f32x4 ww[8];
#pragma unroll
      for (int j = 0; j < 8; ++j) ww[j] = wr4[64 * j];
      f32x4 v[8], vn[8];
#define P0_ROWSRC(m_) ((m_) < SEQ ? a.in[0] + (size_t)(m_) * D : a.in[1] + (size_t)((m_) - SEQ) * D)
      int m = gw;
      if (m < SEQ + NMETA) { const f32x4* xr = (const f32x4*)P0_ROWSRC(m) + lane;
#pragma unroll
          for (int j = 0; j < 8; ++j) v[j] = xr[64 * j]; }
      for (; m < SEQ + NMETA; m += NGW) {
          const int mn = m + NGW; const bool hn = mn < SEQ + NMETA;
          if (hn) { const f32x4* xr = (const f32x4*)P0_ROWSRC(mn) + lane;
#pragma unroll
              for (int j = 0; j < 8; ++j) vn[j] = xr[64 * j]; }
          float sq = 0.f;
#pragma unroll
          for (int j = 0; j < 8; ++j) sq += (v[j].x * v[j].x + v[j].y * v[j].y) + (v[j].z * v[j].z + v[j].w * v[j].w);
          const float rstd = rsqrtf(wave_sum(sq) * (1.f / D) + EPS);
          u32x2* o8 = (u32x2*)(m < SEQ ? (bf16_t*)(ws + WS_XN) + (size_t)m * D : (bf16_t*)(ws + WS_XNM) + (size_t)(m - SEQ) * D) + lane;
#pragma unroll
          for (int j = 0; j < 8; ++j) { u32x2 o; o.x = cvtpk(v[j].x * rstd * ww[j].x, v[j].y * rstd * ww[j].y); o.y = cvtpk(v[j].z * rstd * ww[j].z, v[j].w * rstd * ww[j].w); o8[64 * j] = o; }
          if (hn) {
#pragma unroll
              for (int j = 0; j < 8; ++j) v[j] = vn[j]; }
      }
#undef P0_ROWSRC
    }
}

__device__ __forceinline__ void meta_stage1(Frame& F) {
    const Ids I = phase_ids(F.wave);
    unsigned char* ws = F.ws; const int lane = I.lane, c16 = lane & 15, q4 = lane >> 4;
    LAS f32x4* part = (LAS f32x4*)(F.lds + 131072);
    for (int item = (int)blockIdx.x; item < 100; item += F.G) {
        const int nb = item < 32 ? 512 + 16 * item : (item < 96 ? 1024 + 16 * (item - 32) : 6144 + 16 * (item - 96));
        const bf16_t* Ap = (const bf16_t*)(ws + WS_XNM) + (size_t)c16 * D + 8 * q4 + 256 * I.wave;
        const bf16_t* Bp = (const bf16_t*)(ws + WS_WIN) + (size_t)(nb + c16) * D + 8 * q4 + 256 * I.wave;
        f32x4 acc = {0.f, 0.f, 0.f, 0.f};
#pragma unroll
        for (int ks = 0; ks < 8; ++ks) { const bf16x8 av = *(const bf16x8*)(Ap + 32 * ks), bv = *(const bf16x8*)(Bp + 32 * ks); acc = __builtin_amdgcn_mfma_f32_16x16x32_bf16(av, bv, acc, 0, 0, 0); }
        part[I.wave * 64 + lane] = acc;
        __syncthreads();
        if (I.wave == 0) {
            acc = part[lane];
#pragma unroll
            for (int w = 1; w < 8; ++w) acc += part[w * 64 + lane];
            if (item < 32) { float* CK = (float*)(ws + WS_XNM + 65536);
#pragma unroll
                for (int r = 0; r < 4; ++r) CK[(4 * q4 + r) * 512 + 16 * item + c16] = acc[r]; }
            else if (item < 96) { bf16_t* U = (bf16_t*)(ws + WS_U);
#pragma unroll
                for (int r = 0; r < 4; ++r) U[(size_t)(4 * q4 + r) * 1024 + 16 * (item - 32) + c16] = f2bf(acc[r]); }
            else { const int col = 16 * (item - 96) + c16, ii = col >> 1; const f32x2* RT = (const f32x2*)(ws + WS_ROPE); bf16_t* KRm = (bf16_t*)(ws + WS_KR);
#pragma unroll
                for (int r = 0; r < 4; ++r) { const int row = 4 * q4 + r; const float own = acc[r], oth = __shfl_xor(own, 1); const f32x2 cs = RT[row * 32 + ii];
                    const float y = (col & 1) ? (oth * cs.y + own * cs.x) : (own * cs.x - oth * cs.y); const bf16_t yb = f2bf(y);
                    KRm[(size_t)(SEQ + row) * 64 + col] = yb; } }
        }
        __syncthreads();
    }
}
__device__ __forceinline__ void weff_stage(Frame& F) {
    const Ids I = phase_ids(F.wave); unsigned char* ws = F.ws; const int lane = I.lane, c16 = lane & 15, q4 = lane >> 4;
    const bf16_t* PWB = (const bf16_t*)(ws + WS_PWB); const bf16_t* WPOT = (const bf16_t*)(ws + WS_WPOT); bf16_t* WPE = (bf16_t*)(ws + WS_WPE);
    for (int q = F.vcu * NWAVES + I.wave; q < 4 * 16 * 32; q += F.G * NWAVES) { const int nq = q & 31, cb = (q >> 5) & 15, g = q >> 9;
        const bf16_t* Ap = PWB + ((size_t)g * 256 + cb * 16 + c16) * 256 + 8 * q4;
        bf16x8 av[8], bv[4][8];
#pragma unroll
        for (int ks = 0; ks < 8; ++ks) av[ks] = *(const bf16x8*)(Ap + 32 * ks);
#pragma unroll
        for (int j = 0; j < 4; ++j) { const bf16_t* Bp = WPOT + (size_t)((nq * 4 + j) * 16 + c16) * 1024 + g * 256 + 8 * q4;
#pragma unroll
            for (int ks = 0; ks < 8; ++ks) bv[j][ks] = *(const bf16x8*)(Bp + 32 * ks); }
#pragma unroll
        for (int j = 0; j < 4; ++j) { const int nb = nq * 4 + j; f32x4 acc = {0.f, 0.f, 0.f, 0.f};
#pragma unroll
            for (int ks = 0; ks < 8; ++ks) acc = __builtin_amdgcn_mfma_f32_16x16x32_bf16(av[ks], bv[j][ks], acc, 0, 0, 0);
            u32x2 o; o.x = cvtpk(acc[0], acc[1]); o.y = cvtpk(acc[2], acc[3]);
            *(u32x2*)(WPE + (size_t)(nb * 16 + c16) * 2048 + g * 256 + cb * 16 + 4 * q4) = o; } }
}
struct SchedP1 { pg8::TileOrder T; const char* A; const char* B;
    __device__ __forceinline__ bool next(int i, pg8::GUnit& u) const { int pm, pn; if (!T.tile(i, pm, pn)) return false; u.pm = pm; u.pn = pn; u.aux = 0; u.nt = 32; u.A = A + (size_t)pm * 256 * 4096; u.B = B + (size_t)pn * 256 * 4096; return true; } };
__device__ __forceinline__ size_t gfrag_off(int pm, int gt, int ai, int m, int bj, int wr, int wc, int fr, int fq) {
    return ((((((size_t)(pm * 16 + gt) * 2 + ai) * 4 + m) * 2 + bj) * 8 + (wr * 4 + wc)) * 64 + (fq * 16 + fr)) * 8; }
struct EpiP1 {
    bf16_t* CQKV; float* SSQ; bf16_t* U; bf16_t* G; bf16_t* Kb; const f32x2* RT;
    __device__ __forceinline__ int nstores(const pg8::GUnit& u) const { return u.pn < 24 ? 16 : 0; }
    __device__ __forceinline__ void operator()(const f32x4 (&acc)[2][2][4][2], const pg8::GUnit& u, int wr, int wc, int fr, int fq) const {
        const int pn = u.pn, row0 = u.pm * 256 + wr * 64 + fr;
        if (pn < 4) {
#pragma unroll
            for (int ai = 0; ai < 2; ++ai)
#pragma unroll
                for (int m = 0; m < 4; ++m) { const int r = row0 + ai * 128 + m * 16;
#pragma unroll
                    for (int bj = 0; bj < 2; ++bj) { const f32x4 v0 = acc[ai][bj][m][0], v1 = acc[ai][bj][m][1];
                        u32x4 w; w.x = cvtpk(v0[0], v0[1]); w.y = cvtpk(v0[2], v0[3]); w.z = cvtpk(v1[0], v1[1]); w.w = cvtpk(v1[2], v1[3]);
                        *(u32x4*)(CQKV + (size_t)r * 2048 + pn * 256 + bj * 128 + wc * 32 + 8 * fq) = w;
                        float s = (v0[0] * v0[0] + v0[1] * v0[1]) + (v0[2] * v0[2] + v0[3] * v0[3]) + (v1[0] * v1[0] + v1[1] * v1[1]) + (v1[2] * v1[2] + v1[3] * v1[3]);
                        s += __shfl_xor(s, 16); s += __shfl_xor(s, 32);
                        if (fq == 0) SSQ[((size_t)(pn >> 1) * SEQ + r) * 16 + (pn & 1) * 8 + bj * 4 + wc] = s; } }
        } else if (pn < 8) {
#pragma unroll
            for (int ai = 0; ai < 2; ++ai)
#pragma unroll
                for (int m = 0; m < 4; ++m) { const int r = row0 + ai * 128 + m * 16;
#pragma unroll
                    for (int bj = 0; bj < 2; ++bj) { const f32x4 v0 = acc[ai][bj][m][0], v1 = acc[ai][bj][m][1];
                        u32x4 w; w.x = cvtpk(v0[0], v0[1]); w.y = cvtpk(v0[2], v0[3]); w.z = cvtpk(v1[0], v1[1]); w.w = cvtpk(v1[2], v1[3]);
                        *(u32x4*)(U + (size_t)(NMETA + r) * 1024 + (pn - 4) * 256 + bj * 128 + wc * 32 + 8 * fq) = w; } }
        } else if (pn < 24) {
#pragma unroll
            for (int ai = 0; ai < 2; ++ai)
#pragma unroll
                for (int m = 0; m < 4; ++m) { const int r = row0 + ai * 128 + m * 16;
#pragma unroll
                    for (int bj = 0; bj < 2; ++bj) { const f32x4 v0 = acc[ai][bj][m][0], v1 = acc[ai][bj][m][1];
                        u32x4 w; w.x = cvtpk(sigmoidf_(v0[0]), sigmoidf_(v0[1])); w.y = cvtpk(sigmoidf_(v0[2]), sigmoidf_(v0[3])); w.z = cvtpk(sigmoidf_(v1[0]), sigmoidf_(v1[1])); w.w = cvtpk(sigmoidf_(v1[2]), sigmoidf_(v1[3]));
                        *(u32x4*)(G + gfrag_off(u.pm, pn - 8, ai, m, bj, wr, wc, fr, fq)) = w; } }
        } else {
            if (wc < 2) {
                const int colr = wc * 32 + 8 * fq, i0 = colr >> 1;
#pragma unroll
                for (int ai = 0; ai < 2; ++ai)
#pragma unroll
                    for (int m = 0; m < 4; ++m) { const int r = row0 + ai * 128 + m * 16; const f32x4 v0 = acc[ai][0][m][0], v1 = acc[ai][0][m][1];
                        const f32x4 cs0 = *(const f32x4*)(RT + (size_t)(r + NMETA) * 32 + i0), cs1 = *(const f32x4*)(RT + (size_t)(r + NMETA) * 32 + i0 + 2);
                        u32x4 w; w.x = cvtpk(v0[0] * cs0[0] - v0[1] * cs0[1], v0[0] * cs0[1] + v0[1] * cs0[0]); w.y = cvtpk(v0[2] * cs0[2] - v0[3] * cs0[3], v0[2] * cs0[3] + v0[3] * cs0[2]);
                        w.z = cvtpk(v1[0] * cs1[0] - v1[1] * cs1[1], v1[0] * cs1[1] + v1[1] * cs1[0]); w.w = cvtpk(v1[2] * cs1[2] - v1[3] * cs1[3], v1[2] * cs1[3] + v1[3] * cs1[2]);
#pragma unroll
                        for (int h = 0; h < NH; ++h) *(u32x4*)(Kb + ((size_t)h * KROWS + r) * QKD + 128 + colr) = w; }
            }
        }
    }
};


template <int W> __device__ __forceinline__ void pool_strip(const bf16_t* U, bf16_t* PL, int p0, int c0) {
    u32x4 v[W + 7];
#pragma unroll
    for (int j = 0; j < W + 7; ++j) v[j] = *(const u32x4*)(U + (size_t)(p0 - W + 1 + j) * 1024 + c0);
    float sum[8];
#pragma unroll
    for (int e = 0; e < 8; ++e) sum[e] = 0.f;
#pragma unroll
    for (int j = 0; j < W - 1; ++j) { sum[0] += bflo(v[j].x); sum[1] += bfhi(v[j].x); sum[2] += bflo(v[j].y); sum[3] += bfhi(v[j].y); sum[4] += bflo(v[j].z); sum[5] += bfhi(v[j].z); sum[6] += bflo(v[j].w); sum[7] += bfhi(v[j].w); }
    constexpr float iw = 1.f / (float)W;
#pragma unroll
    for (int i = 0; i < 8; ++i) { const u32x4 x_ = v[W - 1 + i];
        const float x0 = bflo(x_.x), x1 = bfhi(x_.x), x2 = bflo(x_.y), x3 = bfhi(x_.y), x4 = bflo(x_.z), x5 = bfhi(x_.z), x6 = bflo(x_.w), x7 = bfhi(x_.w);
        sum[0] += x0; sum[1] += x1; sum[2] += x2; sum[3] += x3; sum[4] += x4; sum[5] += x5; sum[6] += x6; sum[7] += x7;
        u32x4 o; o.x = cvtpk(sum[0] * iw - x0, sum[1] * iw - x1); o.y = cvtpk(sum[2] * iw - x2, sum[3] * iw - x3); o.z = cvtpk(sum[4] * iw - x4, sum[5] * iw - x5); o.w = cvtpk(sum[6] * iw - x6, sum[7] * iw - x7);
        *(u32x4*)(PL + (size_t)(p0 + i - NMETA) * 2048 + c0) = o;
        const u32x4 q = v[i];
        sum[0] -= bflo(q.x); sum[1] -= bfhi(q.x); sum[2] -= bflo(q.y); sum[3] -= bfhi(q.y); sum[4] -= bflo(q.z); sum[5] -= bfhi(q.z); sum[6] -= bflo(q.w); sum[7] -= bfhi(q.w); }
}
__device__ __forceinline__ void pool_phase(Frame& F) {
    const Ids I = phase_ids(F.wave);
    const bf16_t* U = (const bf16_t*)(F.ws + WS_U); bf16_t* PL = (bf16_t*)(F.ws + WS_PL);
    const int gt = (F.vcu * NWAVES + I.wave) * 64 + I.lane, NT = F.G * NTHR;
    for (int item = gt; item < 1024 * 128; item += NT) {
        const int cc = item & 127, strip = item >> 7, c0 = cc * 8, g = c0 >> 8, p0 = NMETA + strip * 8;
        if (g == 0) pool_strip<2>(U, PL, p0, c0); else if (g == 1) pool_strip<4>(U, PL, p0, c0); else if (g == 2) pool_strip<8>(U, PL, p0, c0); else pool_strip<16>(U, PL, p0, c0);
    }
}
__device__ __forceinline__ void meta_stage2(Frame& F) {
    const Ids I = phase_ids(F.wave);
    const int bx_ = (int)blockIdx.x; int item;
    if (F.G == 256) { if ((bx_ & 7) != ((bx_ >> 3) & 7)) return; item = (bx_ >> 3) * NWAVES + I.wave; } else { item = bx_ * NWAVES + I.wave; if (item >= 256) return; }
    unsigned char* ws = F.ws; const int lane = I.lane, c16 = lane & 15, q4 = lane >> 4;
    const float* CK = (const float*)(ws + WS_XNM + 65536) + (size_t)c16 * 512;
    float ss = 0.f;
    for (int k = 0; k < 128; k += 4) { const f32x4 v = *(const f32x4*)(CK + q4 * 128 + k); ss += (v[0] * v[0] + v[1] * v[1]) + (v[2] * v[2] + v[3] * v[3]); }
    ss += __shfl_xor(ss, 16); ss += __shfl_xor(ss, 32);
    const float rstd_own = rsqrtf(ss * (1.f / 512.f) + EPS);
    const bf16_t* Bp = (const bf16_t*)(ws + WS_WQKV2) + (size_t)(3072 + 16 * item + c16) * 2048 + 8 * q4;
    f32x4 acc = {0.f, 0.f, 0.f, 0.f};
#pragma unroll 4
    for (int ks = 0; ks < 16; ++ks) { const f32x4 a0 = *(const f32x4*)(CK + 32 * ks + 8 * q4), a1 = *(const f32x4*)(CK + 32 * ks + 8 * q4 + 4);
        u32x4 aw; aw.x = cvtpk(a0[0], a0[1]); aw.y = cvtpk(a0[2], a0[3]); aw.z = cvtpk(a1[0], a1[1]); aw.w = cvtpk(a1[2], a1[3]);
        const bf16x8 bv = *(const bf16x8*)(Bp + 32 * ks); acc = __builtin_amdgcn_mfma_f32_16x16x32_bf16(__builtin_bit_cast(bf16x8, aw), bv, acc, 0, 0, 0); }
    const int cc = 16 * item + c16, h = cc >> 8, d = cc & 255;
    bf16_t* Kb = (bf16_t*)(ws + WS_K); bf16_t* Vb = (bf16_t*)(ws + WS_V);
#pragma unroll
    for (int r = 0; r < 4; ++r) { const int row = 4 * q4 + r; const float rs = __shfl(rstd_own, row); const bf16_t y = f2bf(acc[r] * rs);
        if (d < 128) Kb[((size_t)h * KROWS + SEQ + row) * QKD + d] = y; else Vb[((size_t)h * KROWS + SEQ + row) * VD + d - 128] = y; }
}
constexpr float QSCALE = 0.07216878364870323f * 1.4426950408889634f;
struct SchedP2 { pg8::TileOrder T; const char* A; const char* B; const char* XN; const char* WKR; int nh, hfirst, hstep, only_heavy;
    __device__ __forceinline__ void init(int G, int b, const char* A_, const char* B_, const char* XN_, const char* WKR_) { A = A_; B = B_; XN = XN_; WKR = WKR_;
        if (G == 256) { const int heavy = ((b & 7) == ((b >> 3) & 7)); nh = heavy; hfirst = b >> 3; hstep = 32; only_heavy = heavy;
            const int nb = (b >> 3) + (((b & 7) > ((b >> 3) & 7)) ? 1 : 0); T.init(32, 28, G - 32, b - nb); }
        else { nh = b < 32 ? (31 - b) / G + 1 : 0; hfirst = b; hstep = G; only_heavy = 0; T.init(32, 28, G, b); } }
    __device__ __forceinline__ bool next(int i, pg8::GUnit& u) const {
        if (i < nh) { const int pm = hfirst + i * hstep; u.pm = pm; u.pn = 28; u.aux = 0; u.nt = 32; u.A = XN + (size_t)pm * 256 * 4096; u.B = WKR; return true; }
        if (only_heavy) return false;
        int pm, pn; if (!T.tile(i - nh, pm, pn)) return false; u.pm = pm; u.pn = pn; u.aux = (i - nh) & 3; u.nt = 8;
        u.A = A + (size_t)pm * 256 * 4096 + (pn >= 12 ? 1024 : 0); u.B = B + (size_t)pn * 256 * 4096; return true; } };
struct EpiP2 {
    bf16_t* Q; bf16_t* Kb; bf16_t* Vb; const f32x2* RT; const LAS float* rtab;
    bf16_t* KR = nullptr;
    int abl = 0;
    __device__ __forceinline__ int nstores(const pg8::GUnit& u) const { return (abl || u.pn == 28) ? 0 : 16; }
#ifdef MK_P2ABL
#define P2_ST(p_, v_) do { if (abl & 2) asm volatile("" :: "v"(v_)); else *(u32x4*)(p_) = (v_); } while (0)
#else
#ifdef MK_NTST
#define P2_ST(p_, v_) do { __builtin_nontemporal_store((v_), (u32x4*)(p_)); } while (0)
#else
#define P2_ST(p_, v_) do { *(u32x4*)(p_) = (v_); } while (0)
#endif
#endif
    __device__ __forceinline__ void operator()(const f32x4 (&acc)[2][2][4][2], const pg8::GUnit& u, int wr, int wc, int fr, int fq) const {
        if (abl & 1) { asm volatile("" :: "v"(acc[0][0][0][0]), "v"(acc[1][1][3][1])); return; }
        const int pn = u.pn, rl0 = wr * 64 + fr, row0 = u.pm * 256 + rl0;
        const LAS float* rt = rtab + u.aux * 256;
#define P2_ROT(w, v0, v1, cs0, cs1) do { w.x = cvtpk(v0[0] * cs0[0] - v0[1] * cs0[1], v0[0] * cs0[1] + v0[1] * cs0[0]); w.y = cvtpk(v0[2] * cs0[2] - v0[3] * cs0[3], v0[2] * cs0[3] + v0[3] * cs0[2]); \
            w.z = cvtpk(v1[0] * cs1[0] - v1[1] * cs1[1], v1[0] * cs1[1] + v1[1] * cs1[0]); w.w = cvtpk(v1[2] * cs1[2] - v1[3] * cs1[3], v1[2] * cs1[3] + v1[3] * cs1[2]); } while (0)
        if (pn == 28) {
            if (wc < 2) { const int colr = wc * 32 + 8 * fq, i0 = colr >> 1;
                f32x4 cs[2][4][2];
#pragma unroll
                for (int ai = 0; ai < 2; ++ai)
#pragma unroll
                    for (int m = 0; m < 4; ++m) { const int r = row0 + ai * 128 + m * 16; cs[ai][m][0] = *(const f32x4*)(RT + (size_t)(r + NMETA) * 32 + i0); cs[ai][m][1] = *(const f32x4*)(RT + (size_t)(r + NMETA) * 32 + i0 + 2); }
#pragma unroll
                for (int ai = 0; ai < 2; ++ai)
#pragma unroll
                    for (int m = 0; m < 4; ++m) { const int r = row0 + ai * 128 + m * 16; const f32x4 v0 = acc[ai][0][m][0], v1 = acc[ai][0][m][1];
                        u32x4 w; P2_ROT(w, v0, v1, cs[ai][m][0], cs[ai][m][1]);
                        P2_ST(KR + (size_t)r * 64 + colr, w); } }
        } else if (pn < 12) {
            const int cu = pn * 256 + wc * 32, c0 = cu + 8 * fq, d0 = cu % 192, d1 = (cu + 128) % 192;
            const int bjr = __builtin_amdgcn_readfirstlane(d0 >= 128 ? 0 : (d1 >= 128 ? 1 : -1));
            if (bjr >= 0) {
                const int c = c0 + bjr * 128, h = c / 192, d = c - h * 192, i0 = (d - 128) >> 1;
                const int hu = __builtin_amdgcn_readfirstlane((cu + bjr * 128) / 192), rowu = u.pm * 256 + wr * 64;
                const char* qbu = (const char*)(Q + ((size_t)hu * SEQ + rowu) * QKD); const unsigned qlo = (unsigned)((fr * QKD + d) * 2);
                const char* rtu = (const char*)(RT + (size_t)(rowu + NMETA) * 32); const unsigned rlo = (unsigned)((fr * 32 + i0) * 8);
                (void)h;
                f32x4 csA[4][2], csB[4][2]; u32x4 wq[4];
#define P2_RLOAD(ai, cs_) do { _Pragma("unroll") for (int m = 0; m < 4; ++m) { const int ro = (ai) * 128 + m * 16; cs_[m][0] = *(const f32x4*)(rtu + (size_t)ro * 256 + rlo); cs_[m][1] = *(const f32x4*)(rtu + (size_t)ro * 256 + rlo + 16); } } while (0)
#define P2_RCALC(ai, cs_) do { _Pragma("unroll") for (int m = 0; m < 4; ++m) { const float sc = rt[rl0 + (ai) * 128 + m * 16] * QSCALE; \
                    const f32x4 a0 = bjr ? acc[ai][1][m][0] : acc[ai][0][m][0], a1 = bjr ? acc[ai][1][m][1] : acc[ai][0][m][1]; const f32x4 v0 = a0 * sc, v1 = a1 * sc; \
                    u32x4 w; P2_ROT(w, v0, v1, cs_[m][0], cs_[m][1]); wq[m] = w; } } while (0)
#define P2_RSTORE(ai) do { _Pragma("unroll") for (int m = 0; m < 4; ++m) P2_ST(qbu + (size_t)((ai) * 128 + m * 16) * (QKD * 2) + qlo, wq[m]); } while (0)
                P2_RLOAD(0, csA); P2_RCALC(0, csA); P2_RLOAD(1, csB); P2_RSTORE(0); P2_RCALC(1, csB); P2_RSTORE(1);
#undef P2_RLOAD
#undef P2_RCALC
#undef P2_RSTORE
            }
#pragma unroll
            for (int bj = 0; bj < 2; ++bj) if (bj != bjr) { const int c = c0 + bj * 128, h = c / 192, d = c - h * 192;
                bf16_t* qb = Q + (size_t)h * SEQ * QKD + d;
#pragma unroll
                for (int ai = 0; ai < 2; ++ai)
#pragma unroll
                    for (int m = 0; m < 4; ++m) { const int rl = rl0 + ai * 128 + m * 16; const float sc = rt[rl] * QSCALE; const f32x4 v0 = acc[ai][bj][m][0] * sc, v1 = acc[ai][bj][m][1] * sc;
                        u32x4 w; w.x = cvtpk(v0[0], v0[1]); w.y = cvtpk(v0[2], v0[3]); w.z = cvtpk(v1[0], v1[1]); w.w = cvtpk(v1[2], v1[3]);
                        P2_ST(qb + (size_t)(u.pm * 256 + rl) * QKD, w); } }
        } else { const int h = pn - 12, dc = wc * 32 + 8 * fq;
#pragma unroll
            for (int ai = 0; ai < 2; ++ai)
#pragma unroll
                for (int m = 0; m < 4; ++m) { const int rl = rl0 + ai * 128 + m * 16, r = u.pm * 256 + rl; const float sc = rt[rl];
#pragma unroll
                    for (int bj = 0; bj < 2; ++bj) { const f32x4 v0 = acc[ai][bj][m][0] * sc, v1 = acc[ai][bj][m][1] * sc;
                        u32x4 w; w.x = cvtpk(v0[0], v0[1]); w.y = cvtpk(v0[2], v0[3]); w.z = cvtpk(v1[0], v1[1]); w.w = cvtpk(v1[2], v1[3]);
                        if (bj == 0) P2_ST(Kb + ((size_t)h * KROWS + r) * QKD + dc, w); else P2_ST(Vb + ((size_t)h * KROWS + r) * VD + dc, w); } }
        }
#undef P2_ROT
#undef P2_ST
        (void)row0;
    }
};


constexpr size_t WS_T1 = WS_K;
constexpr size_t WS_MG = WS_Q;
constexpr size_t WS_H1 = WS_G;
constexpr size_t WS_H1B = WS_XN;
constexpr size_t WS_H1S = WS_O;
struct SchedP4 { pg8::TileOrder T; const char* A0; const char* B0; const char* A1; const char* B1; const char* XN; const char* WIN; int sub_lo, sub_n;
    __device__ __forceinline__ bool next(int i, pg8::GUnit& u) const { const int tile = i / sub_n, sub = sub_lo + (i - tile * sub_n); int pm, pn; if (!T.tile(tile, pm, pn)) return false;
        u.pm = pm; u.pn = pn; u.aux = sub; u.nt = sub == 3 ? 16 : 32;
        if (sub < 2) { u.A = XN + (size_t)pm * 256 * 4096; u.B = WIN + (size_t)((sub ? 16 : 8) + pn) * 256 * 4096; }
        else { u.A = (sub == 3 ? A1 : A0) + (size_t)pm * 256 * 4096; u.B = (sub == 3 ? B1 : B0) + (size_t)pn * 256 * 4096; }
        return true; } };
struct EpiP4 {
    bf16_t* G; bf16_t* MG; XcdBarrier bar = {nullptr, 0u, nullptr}; bool do_wait = false;
    __device__ __forceinline__ void after_unit(const pg8::GUnit& u) const { if (u.aux == 1 && do_wait) xcd_wait(bar); }
    static constexpr float GMIN = 1e-20f;
    __device__ __forceinline__ bool carry(const pg8::GUnit& u) const { return u.aux == 2; }
    __device__ __forceinline__ int nstores(const pg8::GUnit& u) const { return u.aux < 2 ? 16 : 0; }
    __device__ __forceinline__ void rescale(f32x4 (&acc)[2][2][4][2], const pg8::GUnit& u, int wr, int wc, int fr, int fq) const {
        const int row0 = u.pm * 256 + wr * 64 + fr, col0 = u.pn * 256 + wc * 32 + 8 * fq;
#pragma unroll
        for (int ai = 0; ai < 2; ++ai) { u32x4 g1[4][2], g2[4][2];
#pragma unroll
            for (int m = 0; m < 4; ++m)
#pragma unroll
                for (int bj = 0; bj < 2; ++bj) { g1[m][bj] = *(const u32x4*)(G + gfrag_off(u.pm, u.pn, ai, m, bj, wr, wc, fr, fq)); g2[m][bj] = *(const u32x4*)(G + gfrag_off(u.pm, 8 + u.pn, ai, m, bj, wr, wc, fr, fq)); }
#pragma unroll
            for (int m = 0; m < 4; ++m)
#pragma unroll
                for (int bj = 0; bj < 2; ++bj) { const u32x4 a = g1[m][bj], b = g2[m][bj];
#define P4_R(x, y) ((x) * __builtin_amdgcn_rcpf(fmaxf((y), GMIN)))
                    const f32x4 r0 = {P4_R(bflo(a.x), bflo(b.x)), P4_R(bfhi(a.x), bfhi(b.x)), P4_R(bflo(a.y), bflo(b.y)), P4_R(bfhi(a.y), bfhi(b.y))};
                    const f32x4 r1 = {P4_R(bflo(a.z), bflo(b.z)), P4_R(bfhi(a.z), bfhi(b.z)), P4_R(bflo(a.w), bflo(b.w)), P4_R(bfhi(a.w), bfhi(b.w))};
#undef P4_R
                    acc[ai][bj][m][0] *= r0; acc[ai][bj][m][1] *= r1; } }
    }
    __device__ __forceinline__ void operator()(const f32x4 (&acc)[2][2][4][2], const pg8::GUnit& u, int wr, int wc, int fr, int fq) const {
        if (u.aux < 2) {
            const int gt = (u.aux ? 8 : 0) + u.pn;
#pragma unroll
            for (int ai = 0; ai < 2; ++ai)
#pragma unroll
                for (int m = 0; m < 4; ++m)
#pragma unroll
                    for (int bj = 0; bj < 2; ++bj) { const f32x4 v0 = acc[ai][bj][m][0], v1 = acc[ai][bj][m][1];
                        u32x4 w; w.x = cvtpk(sigmoidf_(v0[0]), sigmoidf_(v0[1])); w.y = cvtpk(sigmoidf_(v0[2]), sigmoidf_(v0[3])); w.z = cvtpk(sigmoidf_(v1[0]), sigmoidf_(v1[1])); w.w = cvtpk(sigmoidf_(v1[2]), sigmoidf_(v1[3]));
                        *(u32x4*)(G + gfrag_off(u.pm, gt, ai, m, bj, wr, wc, fr, fq)) = w; }
            return; }
        const int row0 = u.pm * 256 + wr * 64 + fr, col0 = u.pn * 256 + wc * 32 + 8 * fq;
        bf16_t* op = MG + (size_t)row0 * 2048 + col0;
        u32x4 g2[2][4][2];
#pragma unroll
        for (int ai = 0; ai < 2; ++ai)
#pragma unroll
            for (int m = 0; m < 4; ++m)
#pragma unroll
                for (int bj = 0; bj < 2; ++bj) g2[ai][m][bj] = *(const u32x4*)(G + gfrag_off(u.pm, 8 + u.pn, ai, m, bj, wr, wc, fr, fq));
#pragma unroll
        for (int ai = 0; ai < 2; ++ai)
#pragma unroll
            for (int m = 0; m < 4; ++m)
#pragma unroll
                for (int bj = 0; bj < 2; ++bj) { const u32x4 g = g2[ai][m][bj]; const f32x4 v0 = acc[ai][bj][m][0], v1 = acc[ai][bj][m][1];
                    u32x4 w; w.x = cvtpk(fmaxf(bflo(g.x), GMIN) * v0[0], fmaxf(bfhi(g.x), GMIN) * v0[1]); w.y = cvtpk(fmaxf(bflo(g.y), GMIN) * v0[2], fmaxf(bfhi(g.y), GMIN) * v0[3]);
                    w.z = cvtpk(fmaxf(bflo(g.z), GMIN) * v1[0], fmaxf(bfhi(g.z), GMIN) * v1[1]); w.w = cvtpk(fmaxf(bflo(g.w), GMIN) * v1[2], fmaxf(bfhi(g.w), GMIN) * v1[3]);
                    *(u32x4*)(op + (size_t)(ai * 128 + m * 16) * 2048 + bj * 128) = w; }
    }
};
struct SchedP5 { pg8::TileOrder T; const char* A; const char* B;
    __device__ __forceinline__ bool next(int i, pg8::GUnit& u) const { int pm, pn; if (!T.tile(i, pm, pn)) return false; u.pm = pm; u.pn = pn; u.aux = 0; u.nt = 32; u.A = A + (size_t)pm * 256 * 4096; u.B = B + (size_t)pn * 256 * 4096; return true; } };
struct EpiP5 {
    const float* X; float* H1; bf16_t* H1B; float* SS2; bf16_t* H1S; const float* WF; XcdBarrier bar = {nullptr, 0u, nullptr}; bool do_wait = false;
    __device__ __forceinline__ void after_init() const { if (do_wait) xcd_wait(bar); }
    __device__ __forceinline__ void init(f32x4 (&acc)[2][2][4][2], const pg8::GUnit& u, int wr, int wc, int fr, int fq) const {
        const int row0 = u.pm * 256 + wr * 64 + fr, col0 = u.pn * 256 + wc * 32 + 8 * fq;
#pragma unroll
        for (int ai = 0; ai < 2; ++ai)
#pragma unroll
            for (int m = 0; m < 4; ++m)
#pragma unroll
                for (int bj = 0; bj < 2; ++bj) { const size_t off = (size_t)(row0 + ai * 128 + m * 16) * 2048 + col0 + bj * 128;
                    acc[ai][bj][m][0] = *(const f32x4*)(X + off); acc[ai][bj][m][1] = *(const f32x4*)(X + off + 4); }
    }
    __device__ __forceinline__ void operator()(const f32x4 (&acc)[2][2][4][2], const pg8::GUnit& u, int wr, int wc, int fr, int fq) const {
        const int row0 = u.pm * 256 + wr * 64 + fr, col0 = u.pn * 256 + wc * 32 + 8 * fq;
        f32x4 wf[2][2];
#pragma unroll
        for (int bj = 0; bj < 2; ++bj) { wf[bj][0] = *(const f32x4*)(WF + col0 + bj * 128); wf[bj][1] = *(const f32x4*)(WF + col0 + bj * 128 + 4); }
#pragma unroll
        for (int ai = 0; ai < 2; ++ai)
#pragma unroll
            for (int m = 0; m < 4; ++m) { const int r = row0 + ai * 128 + m * 16;
#pragma unroll
                for (int bj = 0; bj < 2; ++bj) { const int c = col0 + bj * 128; const size_t off = (size_t)r * 2048 + c;
                    const f32x4 t0 = acc[ai][bj][m][0], t1 = acc[ai][bj][m][1];
                    u32x4 w; w.x = cvtpk(t0[0], t0[1]); w.y = cvtpk(t0[2], t0[3]); w.z = cvtpk(t1[0], t1[1]); w.w = cvtpk(t1[2], t1[3]);
                    *(u32x4*)(H1B + off) = w;
                    { const f32x4 f0 = wf[bj][0], f1 = wf[bj][1]; u32x4 ws_; ws_.x = cvtpk(t0[0] * f0[0], t0[1] * f0[1]); ws_.y = cvtpk(t0[2] * f0[2], t0[3] * f0[3]); ws_.z = cvtpk(t1[0] * f1[0], t1[1] * f1[1]); ws_.w = cvtpk(t1[2] * f1[2], t1[3] * f1[3]);
                      *(u32x4*)(H1S + off) = ws_; }
                    float sq = (t0[0] * t0[0] + t0[1] * t0[1]) + (t0[2] * t0[2] + t0[3] * t0[3]) + (t1[0] * t1[0] + t1[1] * t1[1]) + (t1[2] * t1[2] + t1[3] * t1[3]);
                    sq += __shfl_xor(sq, 16); sq += __shfl_xor(sq, 32);
                    if (fq == 0) SS2[(size_t)r * 64 + u.pn * 8 + bj * 4 + wc] = sq; } }
    }
};


constexpr size_t RT_EID = WS_RT, RT_WGT = WS_RT + 65536, RT_RS2 = WS_RT + 131072, RT_CNTB = WS_RT + 196608, RT_OFF = WS_RT + 262144  ,
                 RT_STOK = WS_RT + 327680, RT_SW = WS_RT + 458752, RT_SRS = WS_RT + 589824, RT_SDST = WS_RT + 720896;
constexpr size_t WS_HDN = WS_CQKV;
constexpr size_t WS_Y = WS_K;
__device__ __forceinline__ void router_phase(Frame& F, const Args& a, const int abl = 0, const XcdBarrier sbar = XcdBarrier{nullptr, 0u, nullptr}, const bool do_wait = false) {
    const Ids I = phase_ids(F.wave); const int tid = I.tid;
    unsigned char* ws = F.ws; const int lane = I.lane, c16 = lane & 15, q4 = lane >> 4, wave = I.wave;
    LAS float* red = (LAS float*)F.lds;
    LAS int* hist = (LAS int*)(F.lds + 8 * 32 * 80 * 4);
    LAS float* bia = (LAS float*)(hist + 64);
    bf16x8 bpre[2][5]; float bias_v = 0.f;
    { const bf16_t* Bp0 = (const bf16_t*)(ws + WS_WR) + (size_t)c16 * D + wave * 256 + 8 * q4;
#pragma unroll
      for (int ks = 0; ks < 2; ++ks)
#pragma unroll
          for (int j = 0; j < 5; ++j) bpre[ks][j] = *(const bf16x8*)(Bp0 + (size_t)j * 16 * D + 32 * ks);
      if (tid < 72) bias_v = tid < 8 ? a.in[15][tid] : a.in[17][tid - 8]; }
    if (do_wait) xcd_wait(sbar);
    for (int blk = blockIdx.x; blk < SEQ / 32; blk += F.G) {
        const int row0 = blk * 32;
        const bf16_t* Ap = (const bf16_t*)(ws + WS_H1S) + (size_t)(row0 + c16) * D + wave * 256 + 8 * q4;
        const bf16_t* Bp = (const bf16_t*)(ws + WS_WR) + (size_t)c16 * D + wave * 256 + 8 * q4;
        f32x4 acc[2][5];
#pragma unroll
        for (int r = 0; r < 2; ++r)
#pragma unroll
            for (int j = 0; j < 5; ++j) acc[r][j] = (f32x4){0.f, 0.f, 0.f, 0.f};
        f32x4 sv[16];
        if (tid < 32) { const f32x4* sp = (const f32x4*)((const float*)(ws + WS_SS2) + (size_t)(row0 + tid) * 64);
#pragma unroll
            for (int j = 0; j < 16; ++j) sv[j] = sp[j]; }
        if (!(abl & 1)) {
#pragma unroll
        for (int ks = 0; ks < 2; ++ks) { const bf16x8 av0 = *(const bf16x8*)(Ap + 32 * ks), av1 = *(const bf16x8*)(Ap + (size_t)16 * D + 32 * ks);
#pragma unroll
            for (int j = 0; j < 5; ++j) { const bf16x8 bv = bpre[ks][j];
                acc[0][j] = __builtin_amdgcn_mfma_f32_16x16x32_bf16(av0, bv, acc[0][j], 0, 0, 0); acc[1][j] = __builtin_amdgcn_mfma_f32_16x16x32_bf16(av1, bv, acc[1][j], 0, 0, 0); } }
#pragma unroll 3
        for (int ks = 2; ks < 8; ++ks) { const bf16x8 av0 = *(const bf16x8*)(Ap + 32 * ks), av1 = *(const bf16x8*)(Ap + (size_t)16 * D + 32 * ks);
#pragma unroll
            for (int j = 0; j < 5; ++j) { const bf16x8 bv = *(const bf16x8*)(Bp + (size_t)j * 16 * D + 32 * ks);
                acc[0][j] = __builtin_amdgcn_mfma_f32_16x16x32_bf16(av0, bv, acc[0][j], 0, 0, 0); acc[1][j] = __builtin_amdgcn_mfma_f32_16x16x32_bf16(av1, bv, acc[1][j], 0, 0, 0); } } }
        if (tid < 64) hist[tid] = 0;
        if (tid < 72) bia[tid] = bias_v;
#pragma unroll
        for (int rb = 0; rb < 2; ++rb)
#pragma unroll
            for (int j = 0; j < 5; ++j)
#pragma unroll
                for (int r = 0; r < 4; ++r) red[(wave * 32 + rb * 16 + 4 * q4 + r) * 80 + 16 * j + c16] = acc[rb][j][r];
        __syncthreads();
        if (tid < 32 && !(abl & 2)) { const int t = row0 + tid;
            float ssum = 0.f;
#pragma unroll
            for (int j = 0; j < 16; ++j) { const f32x4 v = sv[j]; ssum += (v[0] + v[1]) + (v[2] + v[3]); }
            const float rstd = rsqrtf(ssum * (1.f / D) + EPS);
            const LAS float* rp = red + tid * 80;
#define RSUM(c_) (((rp[c_] + rp[32 * 80 + (c_)]) + (rp[64 * 80 + (c_)] + rp[96 * 80 + (c_)])) + ((rp[128 * 80 + (c_)] + rp[160 * 80 + (c_)]) + (rp[192 * 80 + (c_)] + rp[224 * 80 + (c_)])))
            float g[8]; float gm = -1e30f; int gi = 0;
#pragma unroll
            for (int i = 0; i < 8; ++i) { g[i] = rstd * RSUM(i) + bia[i]; if (g[i] > gm) { gm = g[i]; gi = i; } }
            float den = 0.f;
#pragma unroll
            for (int i = 0; i < 8; ++i) den += __expf(g[i] - gm);
            const float pg = 1.f / den;
            float e[8];
#pragma unroll
            for (int i = 0; i < 8; ++i) { const int c = 8 + gi * 8 + i; e[i] = rstd * RSUM(c) + bia[c]; }
#undef RSUM
            float v1 = -1e30f; int i1 = 0;
#pragma unroll
            for (int i = 0; i < 8; ++i) if (e[i] > v1) { v1 = e[i]; i1 = i; }
            float v2 = -1e30f; int i2 = 0;
#pragma unroll
            for (int i = 0; i < 8; ++i) if (i != i1 && e[i] > v2) { v2 = e[i]; i2 = i; }
            const float p2 = __expf(v2 - v1), sm = 1.f / (1.f + p2);
            int* eid = (int*)(ws + RT_EID); float* wgt = (float*)(ws + RT_WGT);
            eid[t * 2] = gi * 8 + i1; eid[t * 2 + 1] = gi * 8 + i2; wgt[t * 2] = pg * sm; wgt[t * 2 + 1] = pg * p2 * sm;
            ((float*)(ws + RT_RS2))[t] = rstd;
            atomicAdd((int*)&hist[gi * 8 + i1], 1); atomicAdd((int*)&hist[gi * 8 + i2], 1);
        }
        __syncthreads();
        if (tid < 64 && !(abl & 2)) ((int*)(ws + RT_CNTB))[blk * 64 + tid] = hist[tid];
        __syncthreads();
    }
}
__device__ __forceinline__ void slots_phase(Frame& F, const XcdBarrier sbar = XcdBarrier{nullptr, 0u, nullptr}, const bool do_wait = false) {
    unsigned char* ws = F.ws; const int tid = opaque_tid(F.wave);
    LAS int* tot = (LAS int*)F.lds; LAS int* offs = tot + 64; LAS int* ent = tot + 192; LAS int* pt = tot + 256; LAS int* pb = pt + 512; LAS float* wl = (LAS float*)(pb + 512); LAS float* rl = wl + 64;
    const int* cntb = (const int*)(ws + RT_CNTB); const int* eid = (const int*)(ws + RT_EID);
    int own_e = 0; float own_w = 0.f, own_r = 0.f;
    { const int blk0 = (int)blockIdx.x; if (tid < 64 && blk0 < SEQ / 32) { own_e = eid[blk0 * 64 + tid]; own_w = ((const float*)(ws + RT_WGT))[blk0 * 64 + tid]; own_r = ((const float*)(ws + RT_RS2))[blk0 * 32 + (tid >> 1)]; } }
    if (do_wait) xcd_wait(sbar);
    for (int blk = blockIdx.x; blk < SEQ / 32; blk += F.G) {
        { const int e = tid & 63, part = tid >> 6; int c[32];
#pragma unroll
          for (int i = 0; i < 32; ++i) c[i] = cntb[(32 * part + i) * 64 + e];
          int total = 0, before = 0;
#pragma unroll
          for (int i = 0; i < 32; ++i) { total += c[i]; if (32 * part + i < blk) before += c[i]; }
          pt[part * 64 + e] = total; pb[part * 64 + e] = before; }
        if (tid < 64) { if (blk == (int)blockIdx.x) { ent[tid] = own_e; wl[tid] = own_w; rl[tid] = own_r; } else { ent[tid] = eid[blk * 64 + tid]; wl[tid] = ((const float*)(ws + RT_WGT))[blk * 64 + tid]; rl[tid] = ((const float*)(ws + RT_RS2))[blk * 32 + (tid >> 1)]; } }
        __syncthreads();
        int before = 0;
        if (tid < 64) { int total = 0;
#pragma unroll
            for (int p_ = 0; p_ < 8; ++p_) { total += pt[p_ * 64 + tid]; before += pb[p_ * 64 + tid]; }
            tot[tid] = total; }
        __syncthreads();
        if (tid == 0) { int acc = 0; for (int e = 0; e < 64; ++e) { offs[e] = acc; acc += tot[e]; } offs[64] = acc; }
        __syncthreads();
        if (tid < 64) { int pos = offs[tid] + before;
            int* stok = (int*)(ws + RT_STOK); float* sw = (float*)(ws + RT_SW); float* srs = (float*)(ws + RT_SRS); int* sdst = (int*)(ws + RT_SDST);
            for (int i = 0; i < 64; ++i) if (ent[i] == tid) { const int tk = blk * 32 + (i >> 1); stok[pos] = tk; sw[pos] = wl[i]; srs[pos] = rl[i]; sdst[pos] = blk * 64 + i; ++pos; }
            if (blk == 0) { int* off = (int*)(ws + RT_OFF); off[tid] = offs[tid]; off[128 + tid] = tot[tid]; if (tid == 0) off[64] = offs[64]; }
            LAS int* tp = (LAS int*)(F.lds + MISC_OFF + 5120); LAS int* of = tp + 80; LAS int* cn = tp + 160;
            of[tid] = offs[tid]; cn[tid] = tot[tid];
            if (tid == 0) { int acc = 0; for (int e = 0; e < 64; ++e) { tp[e] = acc; acc += (tot[e] + 383) / 384; } tp[64] = acc; of[64] = offs[64]; } }
        __syncthreads();
    }
}
struct MoeTiles {
    const LAS int* tpre; const LAS int* off; const LAS int* cnt;
    __device__ __forceinline__ bool find(int tl, int& e, int& ti) const { if (tl >= tpre[64]) return false; int lo = 0; for (int k = 32; k > 0; k >>= 1) if (tpre[lo + k] <= tl) lo += k; e = lo; ti = tl - tpre[lo]; return true; }
};
__device__ __forceinline__ MoeTiles moe_tiles_build(Frame& F) {
    const int tid = opaque_tid(F.wave);
    LAS int* tp = (LAS int*)(F.lds + MISC_OFF + 5120); LAS int* of = tp + 80; LAS int* cn = tp + 160;
    const int* off = (const int*)(F.ws + RT_OFF);
    if (tid < 64) { of[tid] = off[tid]; cn[tid] = off[128 + tid]; }
    __syncthreads();
    if (tid == 0) { int acc = 0; for (int e = 0; e < 64; ++e) { tp[e] = acc; acc += (cn[e] + 383) / 384; } tp[64] = acc; of[64] = off[64]; }
    __syncthreads();
    return MoeTiles{tp, of, cn};
}
struct SchedP8 { MoeTiles M; int G, c; const char* A; const char* B; const int* stok;
    __device__ __forceinline__ bool next(int i, pg8::GUnit& u) const { const int uu = i * G + c; int e, ti; if (!M.find(uu >> 2, e, ti)) return false; u.pm = M.off[e] + ti * 256; u.aux = M.off[e] + M.cnt[e]; u.pn = ((uu & 3) << 8) | e; u.nt = 32;
        u.A = A; u.B = B + ((size_t)e * 1024 + (uu & 3) * 256) * 4096; return true; }
    __device__ __forceinline__ unsigned arow(const pg8::GUnit& u, int r) const { const int sl = u.pm + r; const int tk = sl < u.aux ? stok[sl] : 0; return (unsigned)tk * 4096u; } };
struct EpiP8 {
    bf16_t* HDN; const float* srs;
    __device__ __forceinline__ void operator()(const f32x4 (&acc)[2][2][4][2], const pg8::GUnit& u, int wr, int wc, int fr, int fq) const {
        const int pn = u.pn >> 8, j0 = (pn * 256 + wc * 32 + 8 * fq) >> 1;
#pragma unroll
        for (int ai = 0; ai < 2; ++ai)
#pragma unroll
            for (int m = 0; m < 4; ++m) { const int sl = u.pm + ai * 128 + wr * 64 + m * 16 + fr;
                if (sl < u.aux) { const float rs = srs[sl];
#pragma unroll
                    for (int bj = 0; bj < 2; ++bj) { const f32x4 v0 = acc[ai][bj][m][0] * rs, v1 = acc[ai][bj][m][1] * rs;
                        const float h0 = v0[0] * sigmoidf_(v0[0]) * v0[1], h1 = v0[2] * sigmoidf_(v0[2]) * v0[3], h2 = v1[0] * sigmoidf_(v1[0]) * v1[1], h3 = v1[2] * sigmoidf_(v1[2]) * v1[3];
                        u32x2 w; w.x = cvtpk(h0, h1); w.y = cvtpk(h2, h3);
                        *(u32x2*)(HDN + (size_t)sl * 512 + j0 + bj * 64) = w; } } }
    }
};
struct SchedP9 { MoeTiles M; int G, c; const char* A; const char* B;
    __device__ __forceinline__ bool next(int i, pg8::GUnit& u) const { const int uu = i * G + c; int e, ti; if (!M.find(uu >> 3, e, ti)) return false; u.pm = M.off[e] + ti * 256; u.aux = M.off[e] + M.cnt[e]; u.pn = uu & 7; u.nt = 8;
        u.A = A + (size_t)u.pm * 1024; u.B = B + ((size_t)e * 2048 + (uu & 7) * 256) * 1024; return true; } };
struct EpiP9 {
    bf16_t* Y; const float* sw; const int* sdst;
    __device__ __forceinline__ void operator()(const f32x4 (&acc)[2][2][4][2], const pg8::GUnit& u, int wr, int wc, int fr, int fq) const {
        const int col0 = u.pn * 256 + wc * 32 + 8 * fq;
#pragma unroll
        for (int ai = 0; ai < 2; ++ai)
#pragma unroll
            for (int m = 0; m < 4; ++m) { const int sl = u.pm + ai * 128 + wr * 64 + m * 16 + fr;
                if (sl < u.aux) { const float w_ = sw[sl]; bf16_t* yp = Y + (size_t)sdst[sl] * 2048 + col0;
#pragma unroll
                    for (int bj = 0; bj < 2; ++bj) { const f32x4 v0 = acc[ai][bj][m][0] * w_, v1 = acc[ai][bj][m][1] * w_;
                        u32x4 w; w.x = cvtpk(v0[0], v0[1]); w.y = cvtpk(v0[2], v0[3]); w.z = cvtpk(v1[0], v1[1]); w.w = cvtpk(v1[2], v1[3]);
                        *(u32x4*)(yp + bj * 128) = w; } } }
    }
};

struct SchedM4Up { MoeTiles M; int G, c; const char* A; const float* Wg; const float* Wu; const int* stok;
    __device__ __forceinline__ bool next(int i, m4::MUnit& u) const { int tl, ns; if ((G & 63) == 0) { const int x = c & 7, j = c >> 3, tpx = G >> 6; tl = (i * 8 + x) * tpx + (j >> 3); ns = j & 7; } else { const int uu = i * G + c; tl = uu >> 3; ns = uu & 7; }
        int e, ti; if (!M.find(tl, e, ti)) return false; u.pm = M.off[e] + ti * 384; u.aux = M.off[e] + M.cnt[e]; u.ns = ns; u.nK = 64; u.koff = (e * 8 + ns) * 13;
        u.A = A; u.B0 = Wg + (size_t)e * 2048 * 512 + 64 * ns; u.B1 = Wu + (size_t)e * 2048 * 512 + 64 * ns; return true; }
    __device__ __forceinline__ unsigned arow(const m4::MUnit& u, int r) const { const int sl = u.pm + r; const int tk = sl < u.aux ? stok[sl] : 0; return (unsigned)tk * 4096u; } };
struct EpiM4Up {
    bf16_t* HDN; const float* srs;
    __device__ __forceinline__ void operator()(const f32x4 (&acc)[3][8], const m4::MUnit& u, int wid, int fr, int fq) const {
        float rsv[3];
#pragma unroll
        for (int m = 0; m < 3; ++m) { const int sl = u.pm + 48 * wid + 16 * m + fr; rsv[m] = srs[min(sl, u.aux - 1)]; }
        asm volatile("" : "+v"(rsv[0]), "+v"(rsv[1]), "+v"(rsv[2]));
#pragma unroll
        for (int m = 0; m < 3; ++m) { const int sl = u.pm + 48 * wid + 16 * m + fr;
            if (sl < u.aux && 48 * wid + 16 * m + fr < m4::ROWS) { const float rs = rsv[m];
#pragma unroll
                for (int g = 0; g < 4; ++g) { const f32x4 v0 = acc[m][2 * g] * rs, v1 = acc[m][2 * g + 1] * rs;
                    const float h0 = v0[0] * sigmoidf_(v0[0]) * v0[1], h1 = v0[2] * sigmoidf_(v0[2]) * v0[3], h2 = v1[0] * sigmoidf_(v1[0]) * v1[1], h3 = v1[2] * sigmoidf_(v1[2]) * v1[3];
                    u32x2 w; w.x = cvtpk(h0, h1); w.y = cvtpk(h2, h3);
                    *(u32x2*)(HDN + ((size_t)(2 * u.ns + (g >> 1)) * m4::HDN_SLOTS + sl) * 32 + 16 * (g & 1) + 4 * fq) = w; } } }
    }
};
struct SchedM4Down { MoeTiles M; int G, c; const char* A; const float* Wd;
    __device__ __forceinline__ bool next(int i, m4::MUnit& u) const { int tl, ns; if ((G & 127) == 0) { const int x = c & 7, j = c >> 3, tpx = G >> 7; tl = (i * 8 + x) * tpx + (j >> 4); ns = j & 15; } else { const int uu = i * G + c; tl = uu >> 4; ns = uu & 15; }
        int e, ti; if (!M.find(tl, e, ti)) return false; u.pm = M.off[e] + ti * 384; u.aux = M.off[e] + M.cnt[e]; u.ns = ns; u.nK = 16; u.koff = (e * 16 + ns) * 5;
        u.A = A + (size_t)u.pm * 64; u.B0 = Wd + (size_t)e * 512 * 2048 + 128 * ns; u.B1 = nullptr; return true; }
    __device__ __forceinline__ unsigned arow(const m4::MUnit&, int) const { return 0u; } };
struct EpiM4Down {
    bf16_t* Y; const float* sw; const int* sdst;
    __device__ __forceinline__ void operator()(const f32x4 (&acc)[3][8], const m4::MUnit& u, int wid, int fr, int fq) const {
        float swv[3]; int sdv[3];
#pragma unroll
        for (int m = 0; m < 3; ++m) { const int slc = min(u.pm + 48 * wid + 16 * m + fr, u.aux - 1); swv[m] = sw[slc]; sdv[m] = sdst[slc]; }
        asm volatile("" : "+v"(swv[0]), "+v"(swv[1]), "+v"(swv[2]), "+v"(sdv[0]), "+v"(sdv[1]), "+v"(sdv[2]));
#pragma unroll
        for (int m = 0; m < 3; ++m) { const int sl = u.pm + 48 * wid + 16 * m + fr;
            if (sl < u.aux) { const float w_ = swv[m]; bf16_t* yp = Y + (size_t)sdv[m] * 2048 + 128 * u.ns + 8 * fq;
#pragma unroll
                for (int g = 0; g < 4; ++g) { const f32x4 v0 = acc[m][2 * g] * w_, v1 = acc[m][2 * g + 1] * w_;
                    u32x4 w; w.x = cvtpk(v0[0], v0[1]); w.y = cvtpk(v0[2], v0[3]); w.z = cvtpk(v1[0], v1[1]); w.w = cvtpk(v1[2], v1[3]);
                    *(u32x4*)(yp + 32 * g) = w; } } }
    }
};
__device__ __forceinline__ void final_phase(Frame& F, const Args& a, const XcdBarrier bar, const bool do_wait) {
    const Ids I = phase_ids(F.wave);
    unsigned char* ws = F.ws; const int gw = F.vcu * NWAVES + I.wave, NGW = F.G * NWAVES, lane = I.lane;
    const f32x4* fwp = (const f32x4*)a.in[21] + lane;
    f32x4 fw[8];
#pragma unroll
    for (int j = 0; j < 8; ++j) fw[j] = fwp[64 * j];
    u32x2 h0[8], h1[8], p0[8], p1[8], q0[8], q1[8];
#define FIN_LOADH(t0_, t1c_) do { const u32x2* hp0 = (const u32x2*)((const bf16_t*)(ws + WS_H1B) + (size_t)(t0_) * D) + lane; const u32x2* hp1 = (const u32x2*)((const bf16_t*)(ws + WS_H1B) + (size_t)(t1c_) * D) + lane; \
        _Pragma("unroll") for (int j = 0; j < 8; ++j) { h0[j] = hp0[64 * j]; h1[j] = hp1[64 * j]; } } while (0)
#define FIN_LOADY(t0_, t1c_) do { const u32x2* ya0 = (const u32x2*)((const bf16_t*)(ws + WS_Y) + (size_t)(2 * (t0_)) * D) + lane; const u32x2* ya1 = (const u32x2*)((const bf16_t*)(ws + WS_Y) + (size_t)(2 * (t1c_)) * D) + lane; \
        _Pragma("unroll") for (int j = 0; j < 8; ++j) { p0[j] = ya0[64 * j]; q0[j] = ya0[D / 4 + 64 * j]; p1[j] = ya1[64 * j]; q1[j] = ya1[D / 4 + 64 * j]; } } while (0)
#define FIN_LOAD(t0_, t1c_) do { FIN_LOADH(t0_, t1c_); FIN_LOADY(t0_, t1c_); } while (0)
    int t0 = gw;
    if (t0 < SEQ) { const int t1 = t0 + NGW; FIN_LOADH(t0, t1 < SEQ ? t1 : t0); }
    if (do_wait) xcd_wait(bar);
    if (t0 < SEQ) { const int t1 = t0 + NGW; FIN_LOADY(t0, t1 < SEQ ? t1 : t0); }
    for (; t0 < SEQ; t0 += 2 * NGW) {
        const int t1 = t0 + NGW; const bool has1 = t1 < SEQ; const int t1c = has1 ? t1 : t0;
        f32x4 v0[8], v1[8]; float s0 = 0.f, s1 = 0.f;
#pragma unroll
        for (int j = 0; j < 8; ++j) {
            v0[j] = (f32x4){bflo(h0[j].x) + bflo(p0[j].x) + bflo(q0[j].x), bfhi(h0[j].x) + bfhi(p0[j].x) + bfhi(q0[j].x), bflo(h0[j].y) + bflo(p0[j].y) + bflo(q0[j].y), bfhi(h0[j].y) + bfhi(p0[j].y) + bfhi(q0[j].y)};
            v1[j] = (f32x4){bflo(h1[j].x) + bflo(p1[j].x) + bflo(q1[j].x), bfhi(h1[j].x) + bfhi(p1[j].x) + bfhi(q1[j].x), bflo(h1[j].y) + bflo(p1[j].y) + bflo(q1[j].y), bfhi(h1[j].y) + bfhi(p1[j].y) + bfhi(q1[j].y)};
            s0 += (v0[j][0] * v0[j][0] + v0[j][1] * v0[j][1]) + (v0[j][2] * v0[j][2] + v0[j][3] * v0[j][3]);
            s1 += (v1[j][0] * v1[j][0] + v1[j][1] * v1[j][1]) + (v1[j][2] * v1[j][2] + v1[j][3] * v1[j][3]); }
        const int n0 = t0 + 2 * NGW;
        if (n0 < SEQ) { const int n1 = n0 + NGW; FIN_LOAD(n0, n1 < SEQ ? n1 : n0); }
        const float r0 = rsqrtf(wave_sum(s0) * (1.f / D) + EPS), r1 = rsqrtf(wave_sum(s1) * (1.f / D) + EPS);
        f32x4* o0 = (f32x4*)(a.out + (size_t)t0 * D) + lane; f32x4* o1 = (f32x4*)(a.out + (size_t)t1c * D) + lane;
#pragma unroll
        for (int j = 0; j < 8; ++j) { o0[64 * j] = v0[j] * r0 * fw[j]; if (has1) o1[64 * j] = v1[j] * r1 * fw[j]; }
    }
#undef FIN_LOAD
#undef FIN_LOADH
#undef FIN_LOADY
}
template <int DEPTH> __device__ __forceinline__ void stream_probe(Frame& F, const char* base, size_t bytes) {
    const Ids I = phase_ids(F.wave); const int gw = F.vcu * NWAVES + I.wave, NGW = F.G * NWAVES;
    const size_t per = (bytes / NGW) & ~(size_t)1023; const char* p0 = base + (size_t)gw * per; const int np = (int)(per >> 10);
    const unsigned ldsb = (unsigned)(size_t)F.lds + (unsigned)I.wave * 16384u; const unsigned voff = (unsigned)I.lane * 16u;
    for (int i = 0; i < np; ++i) { const char* b_ = p0 + (size_t)i * 1024; unsigned keep_; const unsigned d_ = (unsigned)__builtin_amdgcn_readfirstlane((int)(ldsb + (i & 15) * 1024));
        asm volatile("s_mov_b32 %0, m0\n\ts_mov_b32 m0, %2\n\ts_nop 0\n\tglobal_load_lds_dwordx4 %1, %3 nt\n\ts_mov_b32 m0, %0" : "=&s"(keep_) : "v"(voff), "s"(d_), "s"(b_) : "memory");
        if (DEPTH == 8) asm volatile("s_waitcnt vmcnt(7)" ::: "memory"); else asm volatile("s_waitcnt vmcnt(15)" ::: "memory"); }
    asm volatile("s_waitcnt vmcnt(0)" ::: "memory");
    __syncthreads();
}


template <int DEPTH> __device__ __forceinline__ void stream_probe_sliced(Frame& F, const char* base, size_t bytes) {
    const Ids I = phase_ids(F.wave); const int gw = F.vcu * NWAVES + I.wave, NGW = F.G * NWAVES;
#ifdef MK_PROBE3
    const int bx = blockIdx.x, slice = (bx >> 3) & 7, grpw = ((bx & 7) + 8 * (bx >> 6)) * NWAVES + I.wave, ngrp = NGW >> 3;
#else
    const int grpw = gw >> 3, slice = gw & 7, ngrp = NGW >> 3;
#endif
    const size_t rows_total = bytes >> 11; const size_t rows_per = (rows_total / ngrp) & ~(size_t)3; const char* p0 = base + (size_t)grpw * rows_per * 2048 + slice * 256;
    const int np = (int)(rows_per >> 2);
    const unsigned ldsb = (unsigned)(size_t)F.lds + (unsigned)I.wave * 16384u; const unsigned voff = (unsigned)((I.lane >> 4) * 2048 + (I.lane & 15) * 16);
    for (int i = 0; i < np; ++i) { const char* b_ = p0 + (size_t)i * 8192; unsigned keep_; const unsigned d_ = (unsigned)__builtin_amdgcn_readfirstlane((int)(ldsb + (i & 15) * 1024));
        asm volatile("s_mov_b32 %0, m0\n\ts_mov_b32 m0, %2\n\ts_nop 0\n\tglobal_load_lds_dwordx4 %1, %3 nt\n\ts_mov_b32 m0, %0" : "=&s"(keep_) : "v"(voff), "s"(d_), "s"(b_) : "memory");
        if (DEPTH == 8) asm volatile("s_waitcnt vmcnt(7)" ::: "memory"); else asm volatile("s_waitcnt vmcnt(15)" ::: "memory"); }
    asm volatile("s_waitcnt vmcnt(0)" ::: "memory");
    __syncthreads();
}

__device__ unsigned g_call_ticket = 0u;
__device__ unsigned g_call_ready = 0u;
__global__ void __launch_bounds__(NTHR, 2) mega_fwd(Args args) {
    extern __shared__ __attribute__((aligned(16))) unsigned char lds_raw[];
    Frame F;
    F.lds = (LAS unsigned char*)lds_raw; F.MISC = (volatile LAS unsigned*)(F.lds + MISC_OFF);
    F.G = gridDim.x; { const int bx = blockIdx.x; F.vcu = (F.G % 8 == 0) ? (bx % 8) * (F.G / 8) + bx / 8 : bx; }
    F.ws = args.ws;
    unsigned char* ws = args.ws;
    F.wave = __builtin_amdgcn_readfirstlane((int)(threadIdx.x >> 6));
    for (int u = opaque_tid(F.wave); u < (LDS_BYTES - MISC_OFF) / 4; u += NTHR) ((LAS unsigned*)(F.lds + MISC_OFF))[u] = 0u;
    __syncthreads();
    unsigned* const barw = (unsigned*)(ws + WS_CTL) + CW_BAR;
    if (F.wave == 0) {
        const int l0 = lane_id(); unsigned ticket = 0u;
        if (l0 == 0) { ticket = __hip_atomic_fetch_add(&g_call_ticket, 1u, __ATOMIC_RELAXED, __HIP_MEMORY_SCOPE_AGENT); F.MISC[16] = ticket; }
        if (F.vcu == F.G - 1) {
            const unsigned t0 = (unsigned)__builtin_amdgcn_readfirstlane((int)ticket);
            for (int w = l0; w < XCD_BAR_WORDS; w += 64) __hip_atomic_store(barw + w, 0u, __ATOMIC_RELAXED, __HIP_MEMORY_SCOPE_AGENT);
            asm volatile("s_waitcnt vmcnt(0)" ::: "memory");
            if (l0 == 0) __hip_atomic_store(&g_call_ready, t0 / (unsigned)F.G + 1u, __ATOMIC_RELEASE, __HIP_MEMORY_SCOPE_AGENT);
        }
    }
    XcdBarrier bar; bar.bar = barw; bar.x = xb_xcc_id(); bar.st = F.MISC + 8;
    if (args.never) cg::this_grid().sync();
    const int lo = args.ph_lo, hi = args.ph_hi;
#define IN(k) (lo <= (k) && (k) < hi)
#define SEAM(k) do { if (IN(k) && IN((k) + 1)) xcd_barrier(bar); } while (0)
#ifndef MK_EARLY
#define MK_EARLY true
#endif
#ifndef MK_REPEAT
#define MK_REPEAT -1
#endif
#define REPS(k) for (int rep_ = 0; rep_ < ((k) == MK_REPEAT ? 2 : 1); ++rep_, ((k) == MK_REPEAT && rep_ == 1) ? xcd_barrier(bar) : (void)0)
    if (IN(0)) { p0_prologue<0>(F, args); }
    {
        if (F.wave == 0 && lane_id() == 0) { const unsigned want = F.MISC[16] / (unsigned)F.G + 1u; unsigned sp = 0u;
            while ((int)(__hip_atomic_load(&g_call_ready, __ATOMIC_ACQUIRE, __HIP_MEMORY_SCOPE_AGENT) - want) < 0) { __builtin_amdgcn_s_sleep(1); if (++sp > (1u << 22)) break; }
            (void)xb_add(&barw[XB_XCNT(bar.x)], 1u); }
        __syncthreads(); }
    if (IN(0)) p0_prologue<2>(F, args);
    if (IN(0) && IN(1)) xcd_arrive(bar);
    if (IN(0)) p0_prologue<1>(F, args);
    if (IN(0) && IN(1)) xcd_wait(bar);
    if (IN(1)) REPS(1) {
        meta_stage1(F);
          SchedP1 S; S.T.init(32, 8, F.G, (int)blockIdx.x); S.A = (const char*)(ws + WS_XN); S.B = (const char*)(ws + WS_WIN);
        EpiP1 E{(bf16_t*)(ws + WS_CQKV2), (float*)(ws + WS_SSQ), (bf16_t*)(ws + WS_U), (bf16_t*)(ws + WS_G), (bf16_t*)(ws + WS_K), (const f32x2*)(ws + WS_ROPE)};
        pg8::gemm_phase<EpiP1, SchedP1>(F.wave, F.lds, 4096, 4096, S, E);
    }
    if (IN(1) && IN(2)) xcd_arrive(bar);
    if (IN(1)) weff_stage(F);
    if (IN(1) && IN(2)) xcd_wait(bar);
    if (IN(2)) REPS(2) {
        pool_phase(F);
#ifdef MK_POOLREP
        for (int pr_ = 0; pr_ < MK_POOLREP; ++pr_) { __syncthreads(); pool_phase(F); }
#endif
        meta_stage2(F);
        SchedP2 S; S.init(F.G, (int)blockIdx.x, (const char*)(ws + WS_CQKV2), (const char*)(ws + WS_WQKV2), (const char*)(ws + WS_XN), (const char*)(ws + WS_WIN) + (size_t)6144 * 4096);
        LAS float* rtab = (LAS float*)(F.lds + MISC_OFF + 1024);
        { const float* SSQ = (const float*)(ws + WS_SSQ); pg8::GUnit u; const int tid_ = opaque_tid(F.wave);
          f32x4 sv[5][4]; bool ok[5]; int ax[5];
#pragma unroll
          for (int i = 0; i < 5; ++i) { ok[i] = S.next(i, u) && u.pn != 28 && tid_ < 256; ax[i] = u.aux;
              if (ok[i]) { const f32x4* sp = (const f32x4*)(SSQ + ((size_t)(u.pn >= 12 ? 1 : 0) * SEQ + u.pm * 256 + tid_) * 16);
#pragma unroll
                  for (int j = 0; j < 4; ++j) sv[i][j] = sp[j]; } }
#pragma unroll
          for (int i = 0; i < 5; ++i) if (ok[i]) { const f32x4 a0 = sv[i][0], a1 = sv[i][1], a2 = sv[i][2], a3 = sv[i][3];
              const float ssum = ((a0[0] + a0[1]) + (a0[2] + a0[3])) + ((a1[0] + a1[1]) + (a1[2] + a1[3])) + ((a2[0] + a2[1]) + (a2[2] + a2[3])) + ((a3[0] + a3[1]) + (a3[2] + a3[3]));
              rtab[ax[i] * 256 + tid_] = rsqrtf(ssum * (1.f / 512.f) + EPS); } }
        __syncthreads();
        EpiP2 E{(bf16_t*)(ws + WS_Q), (bf16_t*)(ws + WS_K), (bf16_t*)(ws + WS_V), (const f32x2*)(ws + WS_ROPE), rtab}; E.KR = (bf16_t*)(ws + WS_KR);
#ifdef MK_P2ABL
        E.abl = (rep_ == 1) ? MK_P2ABL : 0;
#endif
        pg8::gemm_phase<EpiP2, SchedP2, false, false, false, MK_EARLY>(F.wave, F.lds, 4096, 4096, S, E);
    }
    if (IN(2) && IN(3)) xcd_arrive(bar);
    if (IN(3)) {
        SchedP4 S; S.T.init(32, 8, F.G, (int)blockIdx.x); S.A0 = S.B0 = S.A1 = S.B1 = nullptr; S.XN = (const char*)(ws + WS_XN); S.WIN = (const char*)(ws + WS_WIN); S.sub_lo = 0; S.sub_n = 1;
        EpiP4 E{(bf16_t*)(ws + WS_G), (bf16_t*)(ws + WS_MG)};
        pg8::gemm_phase<EpiP4, SchedP4>(F.wave, F.lds, 4096, 4096, S, E);
    }
    if (IN(2) && IN(3)) xcd_wait(bar);
    if (IN(3)) {
        for (int pu_ = F.vcu; pu_ < (MK_REPEAT == 3 ? 512 : 256); pu_ += F.G) { const int pu = pu_ & 255, h = pu >> 4, sq = pu & 15;
            at::attn_unit(F.wave, h, 31 - sq, ws, (unsigned)WS_Q, (unsigned)WS_K, (unsigned)WS_V, (unsigned)WS_O, (unsigned)WS_KR, F.lds);
            at::attn_unit(F.wave, h, sq, ws, (unsigned)WS_Q, (unsigned)WS_K, (unsigned)WS_V, (unsigned)WS_O, (unsigned)WS_KR, F.lds); }
    }
    if (IN(3) && IN(4)) xcd_arrive(bar);
    if (IN(4)) REPS(4) {
        SchedP4 S; S.T.init(32, 8, F.G, (int)blockIdx.x); S.A0 = (const char*)(ws + WS_O); S.B0 = (const char*)(ws + WS_WO); S.A1 = (const char*)(ws + WS_PL); S.B1 = (const char*)(ws + WS_WPE);
        S.XN = (const char*)(ws + WS_XN); S.WIN = (const char*)(ws + WS_WIN);
        EpiP4 E{(bf16_t*)(ws + WS_G), (bf16_t*)(ws + WS_MG)};
        S.sub_lo = 1; S.sub_n = 1;
        pg8::gemm_phase<EpiP4, SchedP4>(F.wave, F.lds, 4096, 4096, S, E);
        if (IN(3) && IN(4) && rep_ == 0) xcd_wait(bar);
        S.sub_lo = 2; S.sub_n = 2;
        pg8::gemm_phase<EpiP4, SchedP4, false, false, true>(F.wave, F.lds, 4096, 4096, S, E);
    }
    if (IN(4) && IN(5)) xcd_arrive(bar);
    if (IN(5)) REPS(5) {
        SchedP5 S; S.T.init(32, 8, F.G, (int)blockIdx.x); S.A = (const char*)(ws + WS_MG); S.B = (const char*)(ws + WS_WOUT);
        EpiP5 E{args.in[0], (float*)(ws + WS_H1), (bf16_t*)(ws + WS_H1B), (float*)(ws + WS_SS2), (bf16_t*)(ws + WS_H1S), args.in[13]}; E.bar = bar; E.do_wait = IN(4) && IN(5);
        pg8::gemm_phase<EpiP5, SchedP5, false, true>(F.wave, F.lds, 4096, 4096, S, E);
    }
    if (IN(5) && IN(6)) xcd_arrive(bar);
#ifdef MK_BARPROBE
    if (IN(6)) { for (int i_ = 0; i_ < MK_BARPROBE; ++i_) xcd_barrier(bar); }
#endif
#ifdef MK_P6ABL
    if (IN(6)) REPS(6) router_phase(F, args, rep_ == 1 ? MK_P6ABL : 0);
#else
    if (IN(6)) REPS(6) router_phase(F, args, 0, bar, IN(5) && IN(6) && rep_ == 0);
#endif
    if (IN(6) && IN(7)) xcd_arrive(bar);
    if (IN(7)) REPS(7) slots_phase(F, bar, IN(6) && IN(7) && rep_ == 0);
    if (IN(7) && IN(8)) xcd_arrive(bar);
#ifdef MK_STREAMPROBE2
    if (IN(8)) { stream_probe_sliced<MK_STREAMPROBE2>(F, (const char*)args.in[18], (size_t)64 * 2048 * 512 * 4); stream_probe_sliced<MK_STREAMPROBE2>(F, (const char*)args.in[19], (size_t)64 * 2048 * 512 * 4); stream_probe_sliced<MK_STREAMPROBE2>(F, (const char*)args.in[20], (size_t)64 * 2048 * 512 * 4); xcd_barrier(bar); }
#endif
#ifdef MK_STREAMPROBE
    if (IN(8)) { stream_probe<MK_STREAMPROBE>(F, (const char*)args.in[18], (size_t)64 * 2048 * 512 * 4); stream_probe<MK_STREAMPROBE>(F, (const char*)args.in[19], (size_t)64 * 2048 * 512 * 4); stream_probe<MK_STREAMPROBE>(F, (const char*)args.in[20], (size_t)64 * 2048 * 512 * 4); xcd_barrier(bar); }
#endif
    if (IN(8)) REPS(8) {
        if (!IN(7)) (void)moe_tiles_build(F);
        const MoeTiles M{(LAS int*)(F.lds + MISC_OFF + 5120), (LAS int*)(F.lds + MISC_OFF + 5120) + 80, (LAS int*)(F.lds + MISC_OFF + 5120) + 160};
        SchedM4Up S{M, F.G, (int)blockIdx.x, (const char*)(ws + WS_H1S), args.in[18], args.in[19], (const int*)(ws + RT_STOK)};
        EpiM4Up E{(bf16_t*)(ws + WS_HDN), (const float*)(ws + RT_SRS)};
        m4::moe_phase<0, SchedM4Up, EpiM4Up>(F.wave, F.lds, S, E, args.in[13], bar, IN(7) && IN(8) && rep_ == 0);
#ifdef MK_ABL8
        xcd_barrier(bar);
        m4::moe_phase<0, SchedM4Up, EpiM4Up, MK_ABL8>(F.wave, F.lds, S, E, args.in[13]);
#endif
    }
    if (IN(8) && IN(9)) xcd_arrive(bar);
    if (IN(9)) REPS(9) {
        if (!IN(7)) (void)moe_tiles_build(F);
        const MoeTiles M{(LAS int*)(F.lds + MISC_OFF + 5120), (LAS int*)(F.lds + MISC_OFF + 5120) + 80, (LAS int*)(F.lds + MISC_OFF + 5120) + 160};
        SchedM4Down S{M, F.G, (int)blockIdx.x, (const char*)(ws + WS_HDN), args.in[20]};
        EpiM4Down E{(bf16_t*)(ws + WS_Y), (const float*)(ws + RT_SW), (const int*)(ws + RT_SDST)};
        m4::moe_phase<1, SchedM4Down, EpiM4Down>(F.wave, F.lds, S, E, nullptr, bar, IN(8) && IN(9) && rep_ == 0);
#ifdef MK_ABL9
        xcd_barrier(bar);
        m4::moe_phase<1, SchedM4Down, EpiM4Down, MK_ABL9>(F.wave, F.lds, S, E, nullptr);
#endif
    }
    if (IN(9) && IN(10)) xcd_arrive(bar);
    if (IN(10)) REPS(10) final_phase(F, args, bar, IN(9) && IN(10) && rep_ == 0);
#undef IN
#undef SEAM
}

constexpr int N_PHASES = 11;
static int g_grid = 0;
inline bool mk_setup() {
    if (g_grid != 0) return g_grid > 0;
    int dev = 0, cus = 0, per_cu = 0;
    if (hipGetDevice(&dev) != hipSuccess || hipDeviceGetAttribute(&cus, hipDeviceAttributeMultiprocessorCount, dev) != hipSuccess) { g_grid = -1; return false; }
    if (hipFuncSetAttribute((const void*)mega_fwd, hipFuncAttributeMaxDynamicSharedMemorySize, LDS_BYTES) != hipSuccess) { fprintf(stderr, "mk: hipFuncSetAttribute failed\n"); g_grid = -1; return false; }
    if (hipOccupancyMaxActiveBlocksPerMultiprocessor(&per_cu, (const void*)mega_fwd, NTHR, LDS_BYTES) != hipSuccess || per_cu < 1) { fprintf(stderr, "mk: occupancy query says %d\n", per_cu); (void)hipGetLastError(); g_grid = -1; return false; }
    g_grid = cus;
    return true;
}
inline void mk_launch(void* const* d_in, float* d_out, unsigned char* ws, int ph_lo, int ph_hi, hipStream_t stream) {
    if (!mk_setup()) return;
    Args a{};
    for (int i = 0; i < 22; ++i) a.in[i] = (const float*)d_in[i];
    a.out = d_out; a.ws = ws; a.ph_lo = ph_lo; a.ph_hi = ph_hi; a.never = 0; a.pad = 0;
    void* kargs[] = {&a};
    hipError_t e = hipLaunchCooperativeKernel((const void*)mega_fwd, dim3(g_grid), dim3(NTHR), kargs, LDS_BYTES, stream);
    if (e != hipSuccess) fprintf(stderr, "mk: cooperative launch failed: %s (grid %d)\n", hipGetErrorString(e), g_grid);
}
}
extern "C" void kernel_launch(void* const* d_in, const int* in_sizes, int n_in, void* d_out, int out_size, void* d_ws, size_t ws_size, hipStream_t stream) {
    (void)in_sizes; (void)n_in; (void)ws_size; (void)out_size;
    unsigned char* ws = (unsigned char*)d_ws;
#ifdef MK_MEMSET
    (void)hipMemsetAsync(ws + mk::WS_CTL, 0, mk::CTL_ZERO_BYTES, stream);
#endif
#ifdef MK_SPLIT
    for (int p = 0; p < mk::N_PHASES; ++p) mk::mk_launch(d_in, (float*)d_out, ws, p, p + 1, stream);
#else
    mk::mk_launch(d_in, (float*)d_out, ws, 0, mk::N_PHASES, stream);
#endif
}
```
